# Optimizing an MI355X kernel written in HIP

```python
import math
import jax, jax.numpy as jnp
from jax import lax
import numpy as np

D_MODEL = 4096
BATCH = 4
SEQ = 4096
DEPTH = 1

HEAD_DIM = 128
D_MIX = D_MODEL
W_A = D_MIX // 2
W_B = D_MIX - W_A
G_A = W_A // HEAD_DIM
H_B = W_B // HEAD_DIM
CHUNK = 128
BLK = 128
DILATED = ((128, 1), (512, 4), (2048, 16))
NUM_BUCKETS = 32
MAX_DISTANCE = 2048
D_PLE = 256
EPS = 1e-6
NEG_INF = -1e30
PROJ_SPLITS = (W_A, W_A, W_A, W_B, W_B, W_B, W_B)
D_IN = W_A * 3 + W_B * 4

kernel_name = "hybrid_gmlp_dilated_attn_layer"


def _rmsnorm(x, g):
    xf = x.astype(jnp.float32)
    y = xf * lax.rsqrt(jnp.mean(xf * xf, axis=-1, keepdims=True) + EPS)
    return (y * g.astype(jnp.float32)).astype(x.dtype)


def _layernorm(x, g, b):
    xf = x.astype(jnp.float32)
    mu = jnp.mean(xf, axis=-1, keepdims=True)
    xc = xf - mu
    y = xc * lax.rsqrt(jnp.mean(xc * xc, axis=-1, keepdims=True) + EPS)
    return (y * g.astype(jnp.float32) + b.astype(jnp.float32)).astype(x.dtype)


def _rel_bucket(dist):
    max_exact = NUM_BUCKETS // 2
    d = jnp.maximum(dist, 1).astype(jnp.float32)
    large = max_exact + (jnp.log(d / max_exact) / math.log(MAX_DISTANCE / max_exact)
                         * (NUM_BUCKETS - max_exact)).astype(jnp.int32)
    large = jnp.minimum(large, NUM_BUCKETS - 1)
    return jnp.where(dist < max_exact, dist, large)


def _dilated_window(q, k, v, rel_bias, window, dil):
    b, s, h, dh = q.shape
    span = dil * BLK
    s_pad = -(-s // span) * span
    L = s_pad // dil
    nb = L // BLK
    pad = ((0, 0), (0, s_pad - s), (0, 0), (0, 0))

    def to_sub(t):
        t = jnp.pad(t, pad).reshape(b, L, dil, h, dh).transpose(0, 2, 1, 3, 4)
        return t.reshape(b, dil, nb, BLK, h, dh)

    def with_prev(t):
        prev = jnp.pad(t, ((0, 0), (0, 0), (1, 0), (0, 0), (0, 0), (0, 0)))[:, :, :-1]
        return jnp.concatenate([prev, t], axis=3)

    qs = to_sub(q)
    kc = with_prev(to_sub(k))
    vc = with_prev(to_sub(v))
    logits = jnp.einsum('brnqhd,brnkhd->brnhqk', qs, kc)

    qi = BLK + jnp.arange(BLK)
    kj = jnp.arange(2 * BLK)
    delta = qi[:, None] - kj[None, :]
    band = (delta >= 0) & (delta <= window // dil)
    bucket = _rel_bucket(jnp.clip(delta, 0, None) * dil)
    bias = rel_bias[bucket].astype(jnp.float32).transpose(2, 0, 1)
    has_prev = (jnp.arange(nb)[:, None, None] > 0) | (kj[None, None, :] >= BLK)
    mask = band[None] & has_prev

    logits = jnp.where(mask[None, None, :, None], logits + bias[None, None, None], NEG_INF)
    m = jnp.max(logits, axis=-1, keepdims=True)
    e = jnp.exp(logits - m)
    den = jnp.sum(e, axis=-1, keepdims=True)
    lse = (m + jnp.log(den))[..., 0].transpose(0, 1, 2, 4, 3)
    o = jnp.einsum('brnhqk,brnkhd->brnqhd', e, vc) / den[..., 0].transpose(0, 1, 2, 4, 3)[..., None]

    def from_sub(t):
        rest = t.shape[4:]
        t = t.reshape((b, dil, L) + rest).swapaxes(1, 2)
        return t.reshape((b, s_pad) + rest)[:, :s]

    return from_sub(o), from_sub(lse)


def setup_inputs(seed: int = 0) -> dict:
    key = jax.random.key(seed)
    ks = jax.random.split(key, 17)
    n = lambda k, shape: jax.random.normal(k, shape, dtype=jnp.float32)
    return {
        "x": n(ks[0], (BATCH, SEQ, D_MODEL)),
        "p": n(ks[1], (DEPTH, BATCH, SEQ, D_PLE)),
        "g_pre": 1.0 + 0.02 * n(ks[2], (DEPTH, D_MODEL)),
        "w_in": n(ks[3], (DEPTH, D_MODEL, D_IN)) * D_MODEL ** -0.5,
        "w_s": n(ks[4], (DEPTH, G_A, CHUNK, CHUNK)) * CHUNK ** -0.5,
        "b_s": 1.0 + 0.1 * n(ks[5], (DEPTH, G_A, CHUNK)),
        "ln_v_g": 1.0 + 0.02 * n(ks[6], (DEPTH, W_A)),
        "ln_v_b": 0.02 * n(ks[7], (DEPTH, W_A)),
        "g_q": 1.0 + 0.02 * n(ks[8], (DEPTH, HEAD_DIM)),
        "g_k": 1.0 + 0.02 * n(ks[9], (DEPTH, HEAD_DIM)),
        "rel_bias": 0.1 * n(ks[10], (NUM_BUCKETS, H_B)),
        "g_out_a": 1.0 + 0.02 * n(ks[11], (DEPTH, W_A)),
        "g_out_b": 1.0 + 0.02 * n(ks[12], (DEPTH, W_B)),
        "w_out": n(ks[13], (DEPTH, D_MIX, D_MODEL)) * D_MIX ** -0.5,
        "g_ple": 1.0 + 0.02 * n(ks[14], (DEPTH, D_MODEL)),
        "w_ple_gate": n(ks[15], (DEPTH, D_MODEL, D_MODEL)) * D_MODEL ** -0.5,
        "w_ple_up": n(ks[16], (DEPTH, D_PLE, D_MODEL)) * D_PLE ** -0.5,
    }


def reference(x, p, g_pre, w_in, w_s, b_s, ln_v_g, ln_v_b, g_q, g_k, rel_bias,
              g_out_a, g_out_b, w_out, g_ple, w_ple_gate, w_ple_up):
    b, s, _ = x.shape
    nc = s // CHUNK
    split_idx = [W_A, 2 * W_A, 3 * W_A, 3 * W_A + W_B, 3 * W_A + 2 * W_B, 3 * W_A + 3 * W_B]
    causal = jnp.tril(jnp.ones((CHUNK, CHUNK), dtype=w_s.dtype))
    for i in range(DEPTH):
        hn = _rmsnorm(x, g_pre[i])
        proj = hn @ w_in[i]
        a_u, a_v, a_z, q, k, v, b_z = jnp.split(proj, split_idx, axis=-1)

        a_u = jax.nn.gelu(a_u, approximate=False)
        a_v = _layernorm(jax.nn.gelu(a_v, approximate=False), ln_v_g[i], ln_v_b[i])
        vg = a_v.reshape(b, nc, CHUNK, G_A, HEAD_DIM)
        z = jnp.einsum('gts,bnsgc->bntgc', w_s[i] * causal, vg) \
            + b_s[i].T[None, None, :, :, None]
        y_a = a_u * z.reshape(b, s, W_A)

        qh = _rmsnorm(q.reshape(b, s, H_B, HEAD_DIM), g_q[i]).astype(jnp.float32) * (HEAD_DIM ** -0.5)
        kh = _rmsnorm(k.reshape(b, s, H_B, HEAD_DIM), g_k[i]).astype(jnp.float32)
        vh = v.reshape(b, s, H_B, HEAD_DIM).astype(jnp.float32)
        outs, lses = [], []
        for window, dil in DILATED:
            o_g, l_g = _dilated_window(qh, kh, vh, rel_bias, window, dil)
            outs.append(o_g)
            lses.append(l_g)
        alpha = jax.nn.softmax(jnp.stack(lses, axis=0), axis=0)
        y_b = jnp.sum(alpha[..., None] * jnp.stack(outs, axis=0), axis=0)
        y_b = y_b.reshape(b, s, W_B).astype(x.dtype)

        y = jnp.concatenate([_rmsnorm(y_a, g_out_a[i]) * jax.nn.silu(a_z),
                             _rmsnorm(y_b, g_out_b[i]) * jax.nn.silu(b_z)], axis=-1)
        h = x + y @ w_out[i]

        gate = jax.nn.sigmoid(_rmsnorm(h, g_ple[i]) @ w_ple_gate[i])
        x = h + gate * (p[i] @ w_ple_up[i])
    return x
```

```cpp
#include <hip/hip_runtime.h>
#include <hip/hip_bf16.h>
#include <hip/hip_cooperative_groups.h>
#include <cstdio>
#include <cstdint>
namespace cg = cooperative_groups;
#define LAS __attribute__((address_space(3)))

constexpr int M_TOK = 16384, DM = 4096, DIN = 14336, WBR = 2048, SEQ = 4096, NBATCH = 4, NHEAD = 16, DPLE = 256;
constexpr float EPS = 1e-6f;
constexpr size_t MiB = 1024ull * 1024ull;
constexpr size_t WS_HN = 0;
constexpr size_t WS_WIN = 128 * MiB;
constexpr size_t WS_WOUT = 240 * MiB;
constexpr size_t WS_WG = 272 * MiB;
constexpr size_t WS_WUP = 304 * MiB;
constexpr size_t WS_PB = 306 * MiB;
constexpr size_t WS_LNP = 314 * MiB;
constexpr size_t WS_HSQ = 318 * MiB;
constexpr size_t WS_LSE = 322 * MiB;
constexpr size_t WS_CTL = 326 * MiB;
constexpr size_t WS_PROJ = 330 * MiB;
constexpr size_t WS_OC = 778 * MiB;
constexpr size_t WS_H = 330 * MiB;
constexpr size_t WS_HB = 586 * MiB;
constexpr size_t WS_END = 970 * MiB;
constexpr size_t SEG = (size_t)M_TOK * WBR;
constexpr int LDS_STAGE = 131072, LDS_X = 131072  , LDS_RS = LDS_X + 8192  , LDS_WTAB = LDS_RS + 2048  , LDS_BYTES = LDS_WTAB + 256;
extern __shared__ __attribute__((aligned(16))) unsigned char lds_raw[];
__device__ __forceinline__ int hw_slot() { unsigned v; asm volatile("s_getreg_b32 %0, hwreg(HW_REG_HW_ID, 0, 6)" : "=s"(v)); return (int)v; }
__device__ __forceinline__ int tidx() {
    const int w = __builtin_amdgcn_readfirstlane(((const LAS int*)((LAS unsigned char*)lds_raw + LDS_WTAB))[hw_slot()]);
    return w * 64 + (int)__builtin_amdgcn_mbcnt_hi(~0u, __builtin_amdgcn_mbcnt_lo(~0u, 0u));
}
namespace pg8 {
#define PG8_LAS __attribute__((address_space(3)))
typedef unsigned short bf16_t;
typedef short bf16x8 __attribute__((ext_vector_type(8)));
typedef float f32x4 __attribute__((ext_vector_type(4)));
typedef unsigned u32x4 __attribute__((ext_vector_type(4)));
constexpr int BM = 256, BK = 64, HALF = 128, HTB = HALF * BK * 2  , STAGE_BYTES = 8 * HTB, NXCD = 8, WGM = 8;

__host__ __device__ __forceinline__ int lds_byte(int r, int c) { const int st = (r >> 4) * 2 + (c >> 5), rr = r & 15, cc = c & 31, ob = rr * 64 + cc * 2; return st * 1024 + (ob ^ (((ob >> 9) & 1) << 5)); }
__host__ __device__ __forceinline__ void stage_rc(int b, int& R, int& C) { const int st = b / 1024, sb = b % 1024, swz = sb ^ (((sb >> 9) & 1) << 5); R = (st >> 1) * 16 + swz / 64; C = (st & 1) * 32 + (swz % 64) / 2; }
__host__ __device__ __forceinline__ int perm32(int rho) { const int n = rho >> 4, i = rho & 15; return 8 * (i >> 2) + 4 * n + (i & 3); }

struct Unit { int pm, pn; };
struct Gemm { const bf16_t* A; const bf16_t* Bt; int M, N, K; };

struct StaticOrder {
    int nM, nN, nwg, G, c;
    __host__ __device__ void init(int M, int N, int G_, int c_) { nM = M / BM; nN = N / BM; nwg = nM * nN; G = G_; c = c_; }
    __host__ __device__ bool next(int i, Unit& u) const {
        const long L = (long)i * G + c; if (L >= nwg) return false;
        int wgid = (int)L; { const int q = nwg / NXCD, r = nwg % NXCD, xcd = wgid % NXCD, off = wgid / NXCD; wgid = (xcd < r ? xcd * (q + 1) : r * (q + 1) + (xcd - r) * q) + off; }
        const int nig = WGM * nN, gid = wgid / nig, fm = gid * WGM, gsz = (nM - fm) < WGM ? (nM - fm) : WGM;
        u.pm = fm + ((wgid % nig) % gsz); u.pn = (wgid % nig) / gsz; return true;
    }
    __device__ __forceinline__ void a_ready(const Unit&, int) const {}
    __device__ __forceinline__ void done(const Unit&) const {}
};
}
namespace pg8 {
__device__ __forceinline__ unsigned cvt_pk_bf16(float lo, float hi) { unsigned r; asm volatile("v_cvt_pk_bf16_f32 %0, %1, %2" : "=v"(r) : "v"(lo), "v"(hi)); return r; }
typedef float f32x2 __attribute__((ext_vector_type(2)));
__device__ __forceinline__ f32x2 gelu_pk(f32x2 v) {
    const f32x2 av = __builtin_elementwise_abs(v), d = av * 0.2316418882f + 1.0f;
    f32x2 t; t.x = __builtin_amdgcn_rcpf(d.x); t.y = __builtin_amdgcn_rcpf(d.y);
    f32x2 q = t * 0.5307027145f + (-0.7265760135f); q = q * t + 0.7107068705f; q = q * t + (-0.142248368f); q = q * t + 0.127414796f; q = q * t;
    const f32x2 s = (v * v) * (-0.72134752044f);
    f32x2 e; e.x = __builtin_amdgcn_exp2f(s.x); e.y = __builtin_amdgcn_exp2f(s.y);
    const f32x2 m = v * (q * e), r = v - m;
    f32x2 o; o.x = v.x < 0.f ? m.x : r.x; o.y = v.y < 0.f ? m.y : r.y; return o;
}
}
namespace pg8 {
__device__ __forceinline__ float sigmoidf_(float v) { return __builtin_amdgcn_rcpf(1.0f + __builtin_amdgcn_exp2f(-1.4426950408889634f * v)); }
__device__ __forceinline__ f32x4 gelu4(f32x4 v) { const f32x2 a = gelu_pk((f32x2){v[0], v[1]}), b = gelu_pk((f32x2){v[2], v[3]}); return (f32x4){a.x, a.y, b.x, b.y}; }
__device__ __forceinline__ f32x4 silu4(f32x4 v) { return (f32x4){v[0] * sigmoidf_(v[0]), v[1] * sigmoidf_(v[1]), v[2] * sigmoidf_(v[2]), v[3] * sigmoidf_(v[3])}; }
__device__ __forceinline__ float sq4(f32x4 v) { return (v[0] * v[0] + v[1] * v[1]) + (v[2] * v[2] + v[3] * v[3]); }
__device__ __forceinline__ float sum4(f32x4 v) { return (v[0] + v[1]) + (v[2] + v[3]); }

struct EpiProj {
    static constexpr bool PERM = true, AFTER_DRAIN = false;
    bf16_t* proj; float* lnp; const float* gq; const float* gk; PG8_LAS float* X;
    __device__ __forceinline__ void operator()(const f32x4 (&acc)[2][2][4][2], const Unit& u, int ui, int wr, int wc, int fr, int fq) const {
        const int seg = __builtin_amdgcn_readfirstlane(u.pn >> 3), ct = __builtin_amdgcn_readfirstlane(u.pn & 7);
        const int row0 = u.pm * BM + wr * 64 + fr, col0 = ct * 256 + wc * 32 + 8 * fq;
        bf16_t* base = proj + (size_t)seg * SEG;
        if (seg == 3 || seg == 4) {
#pragma unroll
            for (int ai = 0; ai < 2; ++ai)
#pragma unroll
                for (int m = 0; m < 4; ++m)
#pragma unroll
                    for (int bj = 0; bj < 2; ++bj) {
                        float s = sq4(acc[ai][bj][m][0]) + sq4(acc[ai][bj][m][1]);
                        s += __shfl_xor(s, 16); s += __shfl_xor(s, 32);
                        if (fq == 0) X[((ai * HALF + wr * 64 + m * 16 + fr) * 2 + bj) * 4 + wc] = s;
                    }
            asm volatile("s_waitcnt lgkmcnt(0)" ::: "memory"); __builtin_amdgcn_s_barrier(); asm volatile("" ::: "memory");
            const float* gv = (seg == 3 ? gq : gk) + wc * 32 + 8 * fq;
            const f32x4 g0 = *(const f32x4*)gv, g1 = *(const f32x4*)(gv + 4);
            const float sc = seg == 3 ? 0.08838834764831845f : 1.0f;
#pragma unroll
            for (int ai = 0; ai < 2; ++ai)
#pragma unroll
                for (int m = 0; m < 4; ++m) { bf16_t* rowp = base + (size_t)(row0 + ai * HALF + m * 16) * WBR + col0;
#pragma unroll
                    for (int bj = 0; bj < 2; ++bj) {
                        const f32x4 p = *(const PG8_LAS f32x4*)(X + ((ai * HALF + wr * 64 + m * 16 + fr) * 2 + bj) * 4);
                        const float rs = __builtin_amdgcn_rsqf(((p[0] + p[1]) + (p[2] + p[3])) * (1.0f / 128.0f) + EPS) * sc;
                        const f32x4 v0 = acc[ai][bj][m][0] * rs * g0, v1 = acc[ai][bj][m][1] * rs * g1;
                        u32x4 w; w.x = cvt_pk_bf16(v0[0], v0[1]); w.y = cvt_pk_bf16(v0[2], v0[3]); w.z = cvt_pk_bf16(v1[0], v1[1]); w.w = cvt_pk_bf16(v1[2], v1[3]);
                        *(u32x4*)(rowp + bj * HALF) = w; } }
        } else {
#pragma unroll
            for (int ai = 0; ai < 2; ++ai)
#pragma unroll
                for (int m = 0; m < 4; ++m) { bf16_t* rowp = base + (size_t)(row0 + ai * HALF + m * 16) * WBR + col0; float s1 = 0.f, s2 = 0.f;
#pragma unroll
                    for (int bj = 0; bj < 2; ++bj) { f32x4 v0 = acc[ai][bj][m][0], v1 = acc[ai][bj][m][1];
                        if (seg <= 1) { v0 = gelu4(v0); v1 = gelu4(v1); }
                        else if (seg != 5) { v0 = silu4(v0); v1 = silu4(v1); }
                        if (seg == 1) { s1 += sum4(v0) + sum4(v1); s2 += sq4(v0) + sq4(v1); }
                        u32x4 w; w.x = cvt_pk_bf16(v0[0], v0[1]); w.y = cvt_pk_bf16(v0[2], v0[3]); w.z = cvt_pk_bf16(v1[0], v1[1]); w.w = cvt_pk_bf16(v1[2], v1[3]);
                        *(u32x4*)(rowp + bj * HALF) = w; }
                    if (seg == 1) { s1 += __shfl_xor(s1, 16); s1 += __shfl_xor(s1, 32); s2 += __shfl_xor(s2, 16); s2 += __shfl_xor(s2, 32);
                        if (fq == 0) *(f32x2*)(lnp + ((size_t)(row0 + ai * HALF + m * 16) * 32 + ct * 4 + wc) * 2) = (f32x2){s1, s2}; } }
        }
    }
};
struct EpiH {
    static constexpr bool PERM = false, AFTER_DRAIN = false;
    const float* x; float* H; bf16_t* HB; float* hsq;
    __device__ __forceinline__ void operator()(const f32x4 (&acc)[2][2][4][2], const Unit& u, int ui, int wr, int wc, int fr, int fq) const {
        const int row0 = u.pm * BM + wr * 64 + fr, col0 = u.pn * BM + wc * 32 + 4 * fq;
#pragma unroll
        for (int ai = 0; ai < 2; ++ai)
#pragma unroll
            for (int m = 0; m < 4; ++m) { const int row = row0 + ai * HALF + m * 16; const size_t off = (size_t)row * DM + col0; float s = 0.f;
#pragma unroll
                for (int bj = 0; bj < 2; ++bj)
#pragma unroll
                    for (int n = 0; n < 2; ++n) { const f32x4 h = *(const f32x4*)(x + off + bj * HALF + n * 16) + acc[ai][bj][m][n];
                        *(f32x4*)(H + off + bj * HALF + n * 16) = h; s += sq4(h);
                        typedef unsigned u32x2v __attribute__((ext_vector_type(2))); u32x2v w; w.x = cvt_pk_bf16(h[0], h[1]); w.y = cvt_pk_bf16(h[2], h[3]);
                        *(u32x2v*)(HB + off + bj * HALF + n * 16) = w; }
                s += __shfl_xor(s, 16); s += __shfl_xor(s, 32);
                if (fq == 0) hsq[(size_t)row * 64 + u.pn * 4 + wc] = s;
                asm volatile("" ::: "memory"); }
    }
};
struct EpiU {
    static constexpr bool PERM = false, AFTER_DRAIN = false;
    float* U;
    __device__ __forceinline__ void operator()(const f32x4 (&acc)[2][2][4][2], const Unit& u, int ui, int wr, int wc, int fr, int fq) const {
        const int row0 = u.pm * BM + wr * 64 + fr, col0 = u.pn * BM + wc * 32 + 4 * fq;
#pragma unroll
        for (int ai = 0; ai < 2; ++ai)
#pragma unroll
            for (int m = 0; m < 4; ++m) { float* rowp = U + (size_t)(row0 + ai * HALF + m * 16) * DM + col0;
#pragma unroll
                for (int bj = 0; bj < 2; ++bj)
#pragma unroll
                    for (int n = 0; n < 2; ++n) *(f32x4*)(rowp + bj * HALF + n * 16) = acc[ai][bj][m][n]; }
    }
};
struct EpiOut {
    static constexpr bool PERM = false, AFTER_DRAIN = false;
    const float* H; float* out; PG8_LAS float* RS;
    __device__ __forceinline__ void operator()(const f32x4 (&acc)[2][2][4][2], const Unit& u, int ui, int wr, int wc, int fr, int fq) const {
        const int row0 = u.pm * BM + wr * 64 + fr, col0 = u.pn * BM + wc * 32 + 4 * fq;
#pragma unroll
        for (int ai = 0; ai < 2; ++ai)
#pragma unroll
            for (int m = 0; m < 4; ++m) { const size_t off = (size_t)(row0 + ai * HALF + m * 16) * DM + col0; const float rs = RS[(ui & 1) * 256 + ai * HALF + wr * 64 + m * 16 + fr];
#pragma unroll
                for (int bj = 0; bj < 2; ++bj)
#pragma unroll
                    for (int n = 0; n < 2; ++n) { const f32x4 h = *(const f32x4*)(H + off + bj * HALF + n * 16), uu = *(const f32x4*)(out + off + bj * HALF + n * 16), a = acc[ai][bj][m][n] * rs;
                        const f32x4 g = (f32x4){sigmoidf_(a[0]), sigmoidf_(a[1]), sigmoidf_(a[2]), sigmoidf_(a[3])};
                        *(f32x4*)(out + off + bj * HALF + n * 16) = h + g * uu; }
                asm volatile("" ::: "memory"); }
    }
};
struct RsOrder : StaticOrder {
    const float* hsq; PG8_LAS float* RS;
    __device__ __forceinline__ void a_ready(const Unit& u, int ui) const {
        const int row = tidx() >> 1, half = tidx() & 1; const float* p = hsq + (size_t)(u.pm * BM + row) * 64 + half * 32; float s = 0.f;
#pragma unroll
        for (int i = 0; i < 8; ++i) s += sum4(*(const f32x4*)(p + 4 * i));
        s += __shfl_xor(s, 1);
        if (half == 0) RS[(ui & 1) * 256 + row] = __builtin_amdgcn_rsqf(s * (1.0f / 4096.0f) + EPS);
    }
};
}
namespace pg8 {
template <class Epi, class Sched, bool STAMP = false>
__device__ __forceinline__ void gemm_phase(PG8_LAS unsigned char* lds, const Gemm g, const Sched& S, const Epi& E, unsigned long long* stamps) {
    const int tid = tidx(), wid = __builtin_amdgcn_readfirstlane(tid >> 6), lane = tid & 63, wr = wid >> 2, wc = wid & 3, fr = lane & 15, fq = lane >> 4;
    const int K = g.K, nt = K / BK;
    int ts_lo = 0, ts_hi = 0, nts = 0; const unsigned long long rt_entry = STAMP ? (unsigned long long)wall_clock64() : 0ull;
#define PG8_STAMP() do { if (STAMP && wid == 0 && nts < 64) { const unsigned long long _c = (unsigned long long)clock64(); \
        ts_lo = (lane == nts) ? (int)(unsigned)_c : ts_lo; ts_hi = (lane == nts) ? (int)(unsigned)(_c >> 32) : ts_hi; ++nts; } } while (0)
    PG8_STAMP();
    unsigned voffA[2], voffB[2];
#pragma unroll
    for (int i = 0; i < 2; ++i) { int R, C; stage_rc(tid * 16 + i * 8192, R, C); const int Rb = Epi::PERM ? ((R & ~31) + perm32(R & 31)) : R;
        voffA[i] = (unsigned)(R * K + C) * 2u; voffB[i] = (unsigned)(Rb * K + C) * 2u; }
    const size_t kstep = (size_t)(BK * 2);
    const size_t hstep = (size_t)HALF * K * 2;
    const size_t tstep = 2 * hstep;
    const unsigned ldsw = (unsigned)wid * 1024u;
    const int aoff = lds_byte(wr * 64 + fr, fq * 8), boff = lds_byte(wc * 32 + fr, fq * 8);
#define PG8_SA(b, h) (((b) * 2 + (h)) * HTB)
#define PG8_SB(b, h) ((4 + (b) * 2 + (h)) * HTB)
#define PG8_STAGE(bufoff, gbase, voff) do { _Pragma("unroll") for (int _i = 0; _i < 2; ++_i) \
        __builtin_amdgcn_global_load_lds((const unsigned*)((const char*)(gbase) + (voff)[_i]), (PG8_LAS unsigned*)(lds + (bufoff) + ldsw + _i * 8192), 16, 0, 0); } while (0)
#define PG8_LDA(dst, b, h) do { _Pragma("unroll") for (int m = 0; m < 4; ++m) _Pragma("unroll") for (int k = 0; k < 2; ++k) dst[m][k] = *(const PG8_LAS bf16x8*)(lds + PG8_SA(b, h) + aoff + m * 2048 + k * 1024); } while (0)
#define PG8_LDB(dst, b, h) do { _Pragma("unroll") for (int n = 0; n < 2; ++n) _Pragma("unroll") for (int k = 0; k < 2; ++k) dst[n][k] = *(const PG8_LAS bf16x8*)(lds + PG8_SB(b, h) + boff + n * 2048 + k * 1024); } while (0)
#define PG8_MMA(ai, bj, At, Bt) do { __builtin_amdgcn_s_setprio(1); _Pragma("unroll") for (int m = 0; m < 4; ++m) _Pragma("unroll") for (int n = 0; n < 2; ++n) _Pragma("unroll") for (int k = 0; k < 2; ++k) \
        acc[ai][bj][m][n] = __builtin_amdgcn_mfma_f32_16x16x32_bf16(Bt[n][k], At[m][k], acc[ai][bj][m][n], 0, 0, 0); __builtin_amdgcn_s_setprio(0); } while (0)
#define PG8_WAIT_V(n) asm volatile("s_waitcnt vmcnt(" #n ")" ::: "memory")
#define PG8_WAIT_L(n) asm volatile("s_waitcnt lgkmcnt(" #n ")" ::: "memory")
#define PG8_BAR __builtin_amdgcn_s_barrier()
#define PG8_SCHED __builtin_amdgcn_sched_barrier(0)
    Unit cur, nxt; int ui = 0;
    if (!S.next(0, cur)) return;
    f32x4 acc[2][2][4][2];
#pragma unroll
    for (int a = 0; a < 2; ++a)
#pragma unroll
        for (int b = 0; b < 2; ++b)
#pragma unroll
            for (int m = 0; m < 4; ++m)
#pragma unroll
                for (int n = 0; n < 2; ++n) acc[a][b][m][n] = (f32x4){0.f, 0.f, 0.f, 0.f};
    bf16x8 At[4][2], B0[2][2], B1[2][2];
    const char* cA = (const char*)g.A + (size_t)cur.pm * tstep; const char* cB = (const char*)g.Bt + (size_t)cur.pn * tstep;
    S.a_ready(cur, 0);
    PG8_STAGE(PG8_SB(0, 0), cB, voffB); PG8_STAGE(PG8_SA(0, 0), cA, voffA); PG8_STAGE(PG8_SB(0, 1), cB + hstep, voffB); PG8_STAGE(PG8_SA(0, 1), cA + hstep, voffA);
    if (wr == 1) PG8_BAR;
    PG8_WAIT_V(4); PG8_BAR;
    PG8_STAGE(PG8_SB(1, 0), cB + kstep, voffB); PG8_STAGE(PG8_SA(1, 0), cA + kstep, voffA); PG8_STAGE(PG8_SB(1, 1), cB + hstep + kstep, voffB);
    PG8_WAIT_V(6); PG8_BAR;
    PG8_STAMP();
    for (;;) {
        const bool has_next = S.next(ui + 1, nxt);
        const char* nA = has_next ? (const char*)g.A + (size_t)nxt.pm * tstep : cA; const char* nB = has_next ? (const char*)g.Bt + (size_t)nxt.pn * tstep : cB;
        for (int t = 0; t < nt; t += 2) {
            const bool last = (t == nt - 2);
            const char* a1 = cA + (size_t)(t + 1) * kstep;
            const char* a2 = last ? nA : cA + (size_t)(t + 2) * kstep; const char* b2 = last ? nB : cB + (size_t)(t + 2) * kstep;
            const char* a3 = a2 + kstep; const char* b3 = b2 + kstep;
            if (last && has_next) S.a_ready(nxt, ui + 1);
            PG8_LDB(B0, 0, 0); PG8_SCHED; PG8_LDA(At, 0, 0); PG8_STAGE(PG8_SA(1, 1), a1 + hstep, voffA);
            PG8_WAIT_L(8); PG8_BAR; PG8_WAIT_L(0); PG8_MMA(0, 0, At, B0); PG8_BAR; PG8_SCHED;
            PG8_LDB(B1, 0, 1); PG8_STAGE(PG8_SB(0, 0), b2, voffB);
            PG8_BAR; PG8_WAIT_L(0); PG8_MMA(0, 1, At, B1); PG8_BAR;
            PG8_LDA(At, 0, 1); PG8_STAGE(PG8_SA(0, 0), a2, voffA);
            PG8_BAR; PG8_WAIT_L(0); PG8_MMA(1, 0, At, B0); PG8_BAR; PG8_SCHED;
            PG8_STAGE(PG8_SB(0, 1), b2 + hstep, voffB);
            PG8_WAIT_V(6); PG8_BAR; PG8_MMA(1, 1, At, B1); PG8_BAR;
            PG8_LDB(B0, 1, 0); PG8_SCHED; PG8_LDA(At, 1, 0); PG8_STAGE(PG8_SA(0, 1), a2 + hstep, voffA);
            PG8_WAIT_L(8); PG8_BAR; PG8_WAIT_L(0); PG8_MMA(0, 0, At, B0); PG8_BAR; PG8_SCHED;
            PG8_LDB(B1, 1, 1); PG8_STAGE(PG8_SB(1, 0), b3, voffB);
            PG8_BAR; PG8_WAIT_L(0); PG8_MMA(0, 1, At, B1); PG8_BAR;
            PG8_LDA(At, 1, 1); PG8_STAGE(PG8_SA(1, 0), a3, voffA);
            PG8_BAR; PG8_WAIT_L(0); PG8_MMA(1, 0, At, B0); PG8_BAR; PG8_SCHED;
            PG8_STAGE(PG8_SB(1, 1), b3 + hstep, voffB);
            PG8_WAIT_V(6); PG8_BAR; PG8_MMA(1, 1, At, B1); PG8_BAR;
        }
        PG8_STAMP();
        if constexpr (!Epi::AFTER_DRAIN) { E(acc, cur, ui, wr, wc, fr, fq); S.done(cur); }
        PG8_STAMP();
        if (!has_next) break;
#pragma unroll
        for (int a = 0; a < 2; ++a)
#pragma unroll
            for (int b = 0; b < 2; ++b)
#pragma unroll
                for (int m = 0; m < 4; ++m)
#pragma unroll
                    for (int n = 0; n < 2; ++n) acc[a][b][m][n] = (f32x4){0.f, 0.f, 0.f, 0.f};
        cur = nxt; cA = nA; cB = nB; ++ui;
    }
    PG8_WAIT_V(0);
    if (wr == 0) PG8_BAR;
    PG8_BAR;
    if constexpr (Epi::AFTER_DRAIN) { E.fused(acc, cur, wr, wc, fr, fq, lds, wid, lane); S.done(cur); }
    PG8_STAMP();
    if (STAMP && wid == 0) { stamps[lane] = lane < nts ? (((unsigned long long)(unsigned)ts_hi << 32) | (unsigned)ts_lo) : 0ull;
        if (lane == 62) stamps[62] = rt_entry; if (lane == 63) stamps[63] = (unsigned long long)wall_clock64(); }
#undef PG8_STAMP
#undef PG8_SA
#undef PG8_SB
#undef PG8_STAGE
#undef PG8_LDA
#undef PG8_LDB
#undef PG8_MMA
#undef PG8_WAIT_V
#undef PG8_WAIT_L
#undef PG8_BAR
#undef PG8_SCHED
}
}
namespace att {
constexpr int D = 128; constexpr float THR = 8.f; constexpr bool WSKIP = true;
constexpr float SCALE = 1.0f;
constexpr int NW = 8, QBLK = 32, KVBLK = 64, QB = NW * QBLK;
constexpr int SHM_V = KVBLK * D * 2, SHM_K = KVBLK * D * 2;
constexpr int LDS_BYTES = 2 * SHM_V + 2 * SHM_K + NW * 64 * 4;
constexpr int BT_OFF = LDS_BYTES, BT_N = 320, BT_ZERO = 96;

using bf16 = __hip_bfloat16;
typedef short bf16x8 __attribute__((ext_vector_type(8)));
typedef short s16x4 __attribute__((ext_vector_type(4)));
typedef float f32x16 __attribute__((ext_vector_type(16)));
typedef float f32x4 __attribute__((ext_vector_type(4)));
typedef unsigned u32x4 __attribute__((ext_vector_type(4)));
template <class A, class Bt> struct same_t { static constexpr bool v = false; };
template <class A> struct same_t<A, A> { static constexpr bool v = true; };

#define KSWZ(row, colB) ((row) * 256 + ((colB) ^ (((row) & 7) << 4)))
#define SBAR() __builtin_amdgcn_sched_barrier(0)
__device__ __forceinline__ int v_st(int k, int c) { const int kk = (k & ~0xC) | ((k & 4) << 1) | ((k & 8) >> 1); return ((kk >> 3) * 4 + (c >> 5)) * 512 + ((kk & 7) * 32 + (c & 31)) * 2; }
__device__ __forceinline__ int v_rd_base(int lane) { return ((lane & 3) << 3) | (((lane >> 2) & 3) << 6) | (((lane >> 4) & 1) << 5) | (((lane >> 5) & 1) << 8); }
constexpr int v_rd_off(int d0, int ks, int half) { return d0 * 512 + ks * 4096 + half * 2048; }
__device__ __forceinline__ int crow(int r, int hi) { return (r & 3) + 8 * (r >> 2) + 4 * hi; }
__device__ __forceinline__ unsigned cvtpk(float lo, float hi) {
    unsigned r; asm volatile("v_cvt_pk_bf16_f32 %0, %1, %2" : "=v"(r) : "v"(lo), "v"(hi)); return r;
}
__device__ __forceinline__ bf16x8 pack8(f32x4 a, f32x4 b) {
    u32x4 w = {cvtpk(a[0], a[1]), cvtpk(a[2], a[3]), cvtpk(b[0], b[1]), cvtpk(b[2], b[3])};
    return *reinterpret_cast<bf16x8*>(&w);
}
template <class T> __device__ __forceinline__ bf16x8 load8(const T* p) {
    if constexpr (same_t<T, float>::v) { return pack8(*(const f32x4*)p, *(const f32x4*)(p + 4)); }
    else { return *reinterpret_cast<const bf16x8*>(p); }
}
__device__ __forceinline__ void mask_tile(f32x16& p0, f32x16& p1, int dq, unsigned W, const float* bt) {
    const float NEG = -__builtin_inff();
    const float* b = bt + (dq + BT_ZERO - 64);
#pragma unroll
    for (int r = 0; r < 16; ++r) {
        const int c = (r & 3) + 8 * (r >> 2);
        const float b0 = b[64 - c], b1 = b[32 - c];
        p0[r] = ((unsigned)(dq - c) >= W) ? NEG : p0[r] + b0;
        p1[r] = ((unsigned)(dq - c - 32) >= W) ? NEG : p1[r] + b1;
    }
}
__device__ __forceinline__ void partialSM(f32x16& p0, f32x16& p1, float& m_reg, float& mn, float& alpha) {
    float pmax = p0[0]; for (int r = 1; r < 16; ++r) pmax = fmaxf(pmax, p0[r]); for (int r = 0; r < 16; ++r) pmax = fmaxf(pmax, p1[r]);
    { auto rr = __builtin_amdgcn_permlane32_swap(__float_as_uint(pmax), __float_as_uint(pmax), false, false);
      pmax = fmaxf(__uint_as_float(rr[0]), __uint_as_float(rr[1])); }
    constexpr float C2 = 1.4426950408889634f * SCALE;
    if (__builtin_expect(__all((pmax - m_reg) * SCALE <= THR), 1)) { mn = m_reg; alpha = 1.f; }
    else { mn = fmaxf(m_reg, pmax); alpha = __builtin_amdgcn_exp2f((m_reg - mn) * C2); m_reg = mn; }
    const float mnL = -mn * C2;
    for (int r = 0; r < 16; ++r) p0[r] = fmaf(p0[r], C2, mnL); for (int r = 0; r < 16; ++r) p1[r] = fmaf(p1[r], C2, mnL);
    for (int r = 0; r < 16; ++r) p0[r] = __builtin_amdgcn_exp2f(p0[r]);
}
__device__ __forceinline__ void finishSM(f32x16& p0, f32x16& p1, float alpha, float& l_reg, bf16x8& pa0, bf16x8& pa1, bf16x8& pa2, bf16x8& pa3) {
    for (int r = 0; r < 16; ++r) p1[r] = __builtin_amdgcn_exp2f(p1[r]);
    float ps = 0; for (int r = 0; r < 16; ++r) ps += p0[r]; for (int r = 0; r < 16; ++r) ps += p1[r];
    { auto rr = __builtin_amdgcn_permlane32_swap(__float_as_uint(ps), __float_as_uint(ps), false, false);
      ps = __uint_as_float(rr[0]) + __uint_as_float(rr[1]); }
    l_reg = l_reg * alpha + ps;
#define PK4(P, B_, OUT) do { unsigned a0 = cvtpk(P[B_+0], P[B_+1]), a1 = cvtpk(P[B_+2], P[B_+3]);                          \
        unsigned b0 = cvtpk(P[B_+4], P[B_+5]), b1 = cvtpk(P[B_+6], P[B_+7]);                                             \
        auto r0 = __builtin_amdgcn_permlane32_swap(a0, b0, false, false); auto r1 = __builtin_amdgcn_permlane32_swap(a1, b1, false, false); \
        u32x4 w = {r0[0], r1[0], r0[1], r1[1]}; OUT = *reinterpret_cast<bf16x8*>(&w); } while (0)
    PK4(p0, 0, pa0); PK4(p0, 8, pa1); PK4(p1, 0, pa2); PK4(p1, 8, pa3);
#undef PK4
}
template <int KB, bool SK>
__device__ __forceinline__ void qkt(f32x16& p0, f32x16& p1, const char* K_lds, int r32, int hi, const bf16x8* qr, bool act) {
    if (SK && !act) { const float NEG = -__builtin_inff();
#pragma unroll
        for (int r = 0; r < 16; ++r) { p0[r] = NEG; p1[r] = NEG; } return; }
    p0 = f32x16{}; p1 = f32x16{};
    const char* kb[4];
#pragma unroll
    for (int dd = 0; dd < 4; ++dd) kb[dd] = K_lds + KB * SHM_K + KSWZ(r32, (dd * 16 + hi * 8) * 2);
#pragma unroll
    for (int d0 = 0; d0 < 8; ++d0) { const char* a = kb[d0 & 3] + (d0 >> 2) * 128;
        bf16x8 b0 = *reinterpret_cast<const bf16x8*>(a);
        bf16x8 b1 = *reinterpret_cast<const bf16x8*>(a + 32 * 256);
        p0 = __builtin_amdgcn_mfma_f32_32x32x16_bf16(b0, qr[d0], p0, 0, 0, 0);
        p1 = __builtin_amdgcn_mfma_f32_32x32x16_bf16(b1, qr[d0], p1, 0, 0, 0); }
}
template <int VB, bool SK>
__device__ __forceinline__ void pv_tile(f32x16* o, int vb0, bf16x8 pa0, bf16x8 pa1, bf16x8 pa2, bf16x8 pa3, bool act) {
    if (SK && !act) return;
#define TRRD(dst, off) asm volatile("ds_read_b64_tr_b16 %0, %1 offset:%2" : "=&v"(dst) : "v"(vb0), "i"(off) : "memory")
#define PV_D0(d0) do { s16x4 l0, l1, l2, l3, h0, h1, h2, h3; constexpr int b_ = VB * SHM_V + v_rd_off(d0, 0, 0);     \
        TRRD(l0, b_); TRRD(h0, b_ + 2048); TRRD(l1, b_ + 4096); TRRD(h1, b_ + 6144); TRRD(l2, b_ + 8192); TRRD(h2, b_ + 10240); TRRD(l3, b_ + 12288); TRRD(h3, b_ + 14336); \
        asm volatile("s_waitcnt lgkmcnt(0)" ::: "memory"); SBAR();                 \
        o[d0] = __builtin_amdgcn_mfma_f32_32x32x16_bf16(pa0, (bf16x8){l0[0], l0[1], l0[2], l0[3], h0[0], h0[1], h0[2], h0[3]}, o[d0], 0, 0, 0);   \
        o[d0] = __builtin_amdgcn_mfma_f32_32x32x16_bf16(pa1, (bf16x8){l1[0], l1[1], l1[2], l1[3], h1[0], h1[1], h1[2], h1[3]}, o[d0], 0, 0, 0);   \
        o[d0] = __builtin_amdgcn_mfma_f32_32x32x16_bf16(pa2, (bf16x8){l2[0], l2[1], l2[2], l2[3], h2[0], h2[1], h2[2], h2[3]}, o[d0], 0, 0, 0);   \
        o[d0] = __builtin_amdgcn_mfma_f32_32x32x16_bf16(pa3, (bf16x8){l3[0], l3[1], l3[2], l3[3], h3[0], h3[1], h3[2], h3[3]}, o[d0], 0, 0, 0); } while (0)
    PV_D0(0); PV_D0(1); PV_D0(2); PV_D0(3);
#undef PV_D0
#undef TRRD
}

template <class TIn, class TOut> struct BlockRef { const TIn* Q; const TIn* K; const TIn* V; TOut* O; float* LSE; const float* RB; int P0; int RS; int dil; };
template <class TIn> struct Seam {
    int par;
    bf16x8 qr[8];
    bf16x8 st_v0, st_v1, st_k0, st_k1; f32x4 sf0, sf1, sf2, sf3;
    f32x4 tq[16];
};
__device__ __forceinline__ int swa_jlo(int P0, int W) { const int lowk = P0 - W + 1; return lowk > 0 ? lowk / KVBLK : 0; }
#define ROW(p, k0, rr) ((p) + (size_t)((k0) + (rr)) * RSX + sc)
#define VMW() asm volatile("s_waitcnt vmcnt(0)" ::: "memory")
#define VMWN(n) asm volatile("s_waitcnt vmcnt(%0)" :: "i"(n) : "memory")
#define SLOAD_H(Kp, Vp, k0) do { S.st_v0 = load8<TIn>(ROW(Vp, k0, sr)); S.st_v1 = load8<TIn>(ROW(Vp, k0, 32 + sr));              \
                         S.st_k0 = load8<TIn>(ROW(Kp, k0, sr)); S.st_k1 = load8<TIn>(ROW(Kp, k0, 32 + sr)); } while (0)
#define SWRITE_HK(bf) do { *(bf16x8*)(K_lds + (bf) * SHM_K + kws) = S.st_k0; *(bf16x8*)(K_lds + (bf) * SHM_K + kws + 32 * 256) = S.st_k1; } while (0)
#define SWRITE_HV(bf) do { *(bf16x8*)(V_lds + (bf) * SHM_V + vst0) = S.st_v0; *(bf16x8*)(V_lds + (bf) * SHM_V + vst1) = S.st_v1; } while (0)
#define SWRITE_H(bf) do { SWRITE_HV(bf); SWRITE_HK(bf); } while (0)
#define SLOAD_F(p, k0) do { S.sf0 = *(const f32x4*)ROW(p, k0, sr); S.sf1 = *(const f32x4*)(ROW(p, k0, sr) + 4);                \
                            S.sf2 = *(const f32x4*)ROW(p, k0, 32 + sr); S.sf3 = *(const f32x4*)(ROW(p, k0, 32 + sr) + 4); } while (0)
#define SWRITE_KF(bf) do { *(bf16x8*)(K_lds + (bf) * SHM_K + kws) = pack8(S.sf0, S.sf1); *(bf16x8*)(K_lds + (bf) * SHM_K + kws + 32 * 256) = pack8(S.sf2, S.sf3); } while (0)
#define SWRITE_VF(bf) do { *(bf16x8*)(V_lds + (bf) * SHM_V + vst0) = pack8(S.sf0, S.sf1); *(bf16x8*)(V_lds + (bf) * SHM_V + vst1) = pack8(S.sf2, S.sf3); } while (0)
__device__ __forceinline__ void fill_bias(float* tbl, const float* RB, int dil) {
    const int tid = tidx();
    if (tid < BT_N) { const int delta = tid - BT_ZERO; float v = 0.f;
        if (delta >= 0 && delta <= 128) { const int dist = delta * dil; int bk;
            if (dist < 16) bk = dist; else { const float d = (float)dist; const int lg = 16 + (int)(logf(d / 16.0f) / 4.852030263919617f * 16.0f); bk = lg < 31 ? lg : 31; }
            v = RB[bk * 16]; }
        tbl[tid] = v; }
}
template <class TIn, class TOut>
__device__ __forceinline__ void causal_swa_prime(const BlockRef<TIn, TOut>& cur, int W, char* lds, Seam<TIn>& S) {
    constexpr bool F32 = same_t<TIn, float>::v;
    const int tid = tidx(), wid = __builtin_amdgcn_readfirstlane(tid >> 6), lane = tid & 63, r32 = lane & 31, hi = lane >> 5;
    const int sr = tid >> 4, sc = (tid & 15) * 8, kws = KSWZ(sr, sc * 2); char* K_lds = lds + 2 * SHM_V;
    const int kb0 = swa_jlo(cur.P0, W) * KVBLK; const int RSX = cur.RS;
    S.par = 0; fill_bias((float*)(lds + BT_OFF), cur.RB, cur.dil);
    for (int d0 = 0; d0 < 8; ++d0) S.qr[d0] = load8<TIn>(cur.Q + (size_t)(wid * QBLK + r32) * cur.RS + d0 * 16 + hi * 8);
    if constexpr (F32) { SLOAD_F((const float*)cur.K, kb0); VMW(); SWRITE_KF(0); SBAR(); SLOAD_F((const float*)cur.V, kb0); }
    else { SLOAD_H(cur.K, cur.V, kb0); VMW(); SWRITE_HK(0); }
    __syncthreads();
}
template <class TIn, class TOut>
__device__ __forceinline__ void causal_swa_block(const BlockRef<TIn, TOut>& cur, const BlockRef<TIn, TOut>& nxt, int skv, int W, char* lds, Seam<TIn>& S) {
    constexpr bool F32 = same_t<TIn, float>::v;
    const int tid = tidx(), wid = __builtin_amdgcn_readfirstlane(tid >> 6), lane = tid & 63, r32 = lane & 31, hi = lane >> 5;
    const int j_lo = swa_jlo(cur.P0, W); int RSX = cur.RS;
    const float* bt = (const float*)(lds + BT_OFF) + S.par * BT_N;
    int j_hi = (cur.P0 + QB - 1) / KVBLK + 1; if (j_hi > skv / KVBLK) j_hi = skv / KVBLK;
    const int NT = j_hi - j_lo;
    const int kbn = swa_jlo(nxt.P0, W) * KVBLK;
    const int qlo = cur.P0 + wid * QBLK, qm = qlo + r32 - 4 * hi;
    char* V_lds = lds; char* K_lds = lds + 2 * SHM_V;
    float* ws = (float*)(lds + 2 * SHM_V + 2 * SHM_K) + wid * 64; float* li_l = ws, * al_l = ws + 32;
    float m_reg = -1e30f, l_reg = 0; f32x16 o[4] = {};
    const int sr = tid >> 4, sc = (tid & 15) * 8, vst0 = v_st(sr, sc), vst1 = v_st(32 + sr, sc), kws = KSWZ(sr, sc * 2);
    const int vb0 = (int)(uintptr_t)V_lds + v_rd_base(lane);
    const TIn* Kh = cur.K; const TIn* Vh = cur.V;
#define RESC(a) do { if (__any((a) < 1.f)) { if (hi == 0) al_l[r32] = (a); asm volatile("s_waitcnt lgkmcnt(0)" ::: "memory");              \
                     for (int d_ = 0; d_ < 4; ++d_) for (int r = 0; r < 16; ++r) o[d_][r] *= al_l[crow(r, hi)]; } } while (0)
#define KBASE(t) ((j_lo + (t)) * KVBLK)
#define ACT(t) (KBASE(t) <= qlo + QBLK - 1 && KBASE(t) + KVBLK - 1 >= qlo - W + 1)
#define MASKT(P0_, P1_, t) do { const int kb_ = KBASE(t); if (!SK || ACT(t)) mask_tile(P0_, P1_, qm - kb_, (unsigned)W, bt); } while (0)
    constexpr int NQL = F32 ? 16 : 8;
    constexpr bool SK = WSKIP && !F32;
#define SEAM_K0() do { VMWN(NQL); if constexpr (F32) { SWRITE_KF(0); SBAR(); SLOAD_F((const float*)nxt.V, kbn); } else { SWRITE_HK(0); } SBAR(); } while (0)
    f32x16 pA0, pA1, pB0, pB1; float mnA, mnB, alA, alB; bf16x8 pa0, pa1, pa2, pa3;
    if constexpr (F32) { VMW(); SWRITE_VF(0); SBAR(); } else { SWRITE_HV(0); SBAR(); }
    if (NT > 1) { if constexpr (F32) SLOAD_F((const float*)Kh, KBASE(1)); else SLOAD_H(Kh, Vh, KBASE(1)); }
    SBAR(); qkt<0, SK>(pA0, pA1, K_lds, r32, hi, S.qr, ACT(0));
    if constexpr (F32) { if (NT > 1) { VMW(); SWRITE_KF(1); SBAR(); SLOAD_F((const float*)Vh, KBASE(1)); } }
    MASKT(pA0, pA1, 0); partialSM(pA0, pA1, m_reg, mnA, alA);
    if (NT > 1) { VMW(); if constexpr (F32) { SWRITE_VF(1); SBAR(); if (NT > 2) SLOAD_F((const float*)Kh, KBASE(2)); } else SWRITE_H(1); }
    __syncthreads();
#define HALF_STEP(PX0, PX1, mnX, alX, PY0, PY1, alY, t, KB, VB, SB) do {                                                      \
        SBAR(); qkt<KB, SK>(PX0, PX1, K_lds, r32, hi, S.qr, ACT(t));                                             \
        finishSM(PY0, PY1, alY, l_reg, pa0, pa1, pa2, pa3); SBAR();                                                           \
        if ((t) + 1 < NT) { if constexpr (F32) { VMW(); SWRITE_KF(SB); SBAR(); SLOAD_F((const float*)Vh, KBASE((t) + 1)); }  \
                            else { SLOAD_H(Kh, Vh, KBASE((t) + 1)); } SBAR(); }                                               \
        pv_tile<VB, SK>(o, vb0, pa0, pa1, pa2, pa3, ACT((t) - 1)); MASKT(PX0, PX1, (t)); partialSM(PX0, PX1, m_reg, mnX, alX);                                        \
        __syncthreads();                                                                                                      \
        if ((t) + 1 < NT) { VMW(); if constexpr (F32) { SWRITE_VF(SB); SBAR(); if ((t) + 2 < NT) SLOAD_F((const float*)Kh, KBASE((t) + 2)); } \
                            else { SWRITE_H(SB); } }                                                                          \
        RESC(alX); __syncthreads(); } while (0)
    for (int t = 1; t + 1 < NT; t += 2) {
        HALF_STEP(pB0, pB1, mnB, alB, pA0, pA1, alA, t, 1, 0, 0);
        HALF_STEP(pA0, pA1, mnA, alA, pB0, pB1, alB, t + 1, 0, 1, 1);
    }
    const bool even = (NT & 1) == 0;
    if (even) { SBAR(); qkt<1, SK>(pB0, pB1, K_lds, r32, hi, S.qr, ACT(NT - 1)); SBAR(); }
#define QROW(e) (nxt.Q + (size_t)(wid * QBLK + r32) * nxt.RS + ((e) >> 1) * 16 + hi * 8 + ((e) & 1) * 4)
    RSX = nxt.RS;
    if constexpr (F32) { SLOAD_F((const float*)nxt.K, kbn); SBAR();
#pragma unroll
        for (int e = 0; e < 8; ++e) S.tq[e] = *(const f32x4*)QROW(e); }
    else { SLOAD_H(nxt.K, nxt.V, kbn); SBAR();
#pragma unroll
        for (int d0 = 0; d0 < 8; ++d0) S.qr[d0] = load8<TIn>(nxt.Q + (size_t)(wid * QBLK + r32) * nxt.RS + d0 * 16 + hi * 8); }
    SBAR();
    finishSM(pA0, pA1, alA, l_reg, pa0, pa1, pa2, pa3); SBAR();
    if constexpr (F32) {
#pragma unroll
        for (int e = 8; e < 16; ++e) S.tq[e] = *(const f32x4*)QROW(e); SBAR(); }
#undef QROW
    pv_tile<0, SK>(o, vb0, pa0, pa1, pa2, pa3, ACT(even ? NT - 2 : NT - 1));
    if (even) { MASKT(pB0, pB1, NT - 1); partialSM(pB0, pB1, m_reg, mnB, alB); __syncthreads(); RESC(alB);
        finishSM(pB0, pB1, alB, l_reg, pa0, pa1, pa2, pa3); SBAR(); pv_tile<1, SK>(o, vb0, pa0, pa1, pa2, pa3, ACT(NT - 1)); }
    SBAR(); SEAM_K0();
    if (hi == 0) { li_l[r32] = l_reg; cur.LSE[(size_t)(wid * QBLK + r32) * (size_t)(16 * cur.dil)] = m_reg * SCALE + __logf(l_reg); }
    fill_bias((float*)(lds + BT_OFF) + (S.par ^ 1) * BT_N, nxt.RB, nxt.dil); S.par ^= 1;
    asm volatile("s_waitcnt lgkmcnt(0)" ::: "memory");
    float rli[16];
#pragma unroll
    for (int r = 0; r < 16; ++r) rli[r] = __builtin_amdgcn_rcpf(li_l[crow(r, hi)]);
    TOut* Ow = cur.O + (size_t)(wid * QBLK) * cur.RS + (size_t)(4 * hi) * cur.RS;
#pragma unroll
    for (int r = 0; r < 16; ++r) { const int orow = (r & 3) + 8 * (r >> 2);
#pragma unroll
        for (int d0 = 0; d0 < 4; ++d0) { const float v = o[d0][r] * rli[r];
            if constexpr (same_t<TOut, float>::v) { Ow[(size_t)orow * cur.RS + d0 * 32 + r32] = v; }
            else { const float vn = __shfl_xor(v, 1);
                   if ((r32 & 1) == 0) *(unsigned*)(Ow + (size_t)orow * cur.RS + d0 * 32 + r32) = cvtpk(v, vn); } } }
    if constexpr (F32) {
#pragma unroll
        for (int d0 = 0; d0 < 8; ++d0) S.qr[d0] = pack8(S.tq[2 * d0], S.tq[2 * d0 + 1]); }
    __syncthreads();
#undef RESC
#undef KBASE
#undef ACT
#undef MASKT
#undef SEAM_K0
#undef HALF_STEP
}
#undef ROW
#undef VMW
#undef VMWN
#undef SLOAD_H
#undef SWRITE_HK
#undef SWRITE_HV
#undef SWRITE_H
#undef SLOAD_F
#undef SWRITE_KF
#undef SWRITE_VF
}
typedef unsigned short bf16_t;
typedef short bf16x8 __attribute__((ext_vector_type(8)));
typedef float f32x4 __attribute__((ext_vector_type(4)));
typedef float f32x2 __attribute__((ext_vector_type(2)));
typedef unsigned u32x4 __attribute__((ext_vector_type(4)));
typedef unsigned u32x2 __attribute__((ext_vector_type(2)));
__device__ __forceinline__ unsigned cvtpk2(float lo, float hi) { unsigned r; asm volatile("v_cvt_pk_bf16_f32 %0, %1, %2" : "=v"(r) : "v"(lo), "v"(hi)); return r; }
__device__ __forceinline__ float bf_lo(unsigned w) { return __uint_as_float(w << 16); }
__device__ __forceinline__ float bf_hi(unsigned w) { return __uint_as_float(w & 0xffff0000u); }
__device__ __forceinline__ float wave_sum(float v) {
#pragma unroll
    for (int o = 32; o >= 1; o >>= 1) v += __shfl_xor(v, o);
    return v;
}

__device__ __forceinline__ void p0_rmsnorm_x(const float* __restrict__ x, const float* __restrict__ g, bf16_t* __restrict__ hn, int G) {
    const int lane = tidx() & 63, wid = tidx() >> 6;
    for (int row = blockIdx.x * 8 + wid; row < M_TOK; row += G * 8) {
        const float* xr = x + (size_t)row * DM; f32x4 v[16]; float s = 0.f;
#pragma unroll
        for (int j = 0; j < 8; ++j) { v[2 * j] = *(const f32x4*)(xr + (j * 64 + lane) * 8); v[2 * j + 1] = *(const f32x4*)(xr + (j * 64 + lane) * 8 + 4); }
#pragma unroll
        for (int j = 0; j < 16; ++j) s += (v[j][0] * v[j][0] + v[j][1] * v[j][1]) + (v[j][2] * v[j][2] + v[j][3] * v[j][3]);
        s = wave_sum(s);
        const float rs = __builtin_amdgcn_rsqf(s * (1.0f / DM) + EPS);
#pragma unroll
        for (int j = 0; j < 8; ++j) { const int c = (j * 64 + lane) * 8; const f32x4 g0 = *(const f32x4*)(g + c), g1 = *(const f32x4*)(g + c + 4);
            const f32x4 a = v[2 * j] * rs * g0, b = v[2 * j + 1] * rs * g1;
            u32x4 w; w.x = cvtpk2(a[0], a[1]); w.y = cvtpk2(a[2], a[3]); w.z = cvtpk2(b[0], b[1]); w.w = cvtpk2(b[2], b[3]);
            *(u32x4*)(hn + (size_t)row * DM + c) = w; }
    }
}
__device__ __forceinline__ void p0_transpose(const float* __restrict__ W, const float* __restrict__ sc, bf16_t* __restrict__ Wt, int K, int N, int it0, int G, LAS float* T) {
    const int tid = tidx(), nn = N / 256, ntile = (K / 64) * nn;
    int first = (int)blockIdx.x - (it0 % G); if (first < 0) first += G;
    for (int t = first; t < ntile; t += G) {
        const int k0 = (t / nn) * 64, n0 = (t % nn) * 256;
        f32x4 r[8];
#pragma unroll
        for (int i = 0; i < 8; ++i) { const int idx = i * 512 + tid, k = idx >> 6, n4 = idx & 63; r[i] = *(const f32x4*)(W + (size_t)(k0 + k) * N + n0 + 4 * n4);
            if (sc) r[i] = r[i] * sc[k0 + k]; }
        __syncthreads();
#pragma unroll
        for (int i = 0; i < 8; ++i) { const int idx = i * 512 + tid, k = idx >> 6, n4 = idx & 63; LAS float* d = T + k * 257 + 4 * n4; d[0] = r[i][0]; d[1] = r[i][1]; d[2] = r[i][2]; d[3] = r[i][3]; }
        __syncthreads();
#pragma unroll
        for (int j = 0; j < 4; ++j) { const int idx = j * 512 + tid, kc = idx & 7, n = idx >> 3; const LAS float* s = T + (8 * kc) * 257 + n;
            u32x4 w; w.x = cvtpk2(s[0], s[257]); w.y = cvtpk2(s[2 * 257], s[3 * 257]); w.z = cvtpk2(s[4 * 257], s[5 * 257]); w.w = cvtpk2(s[6 * 257], s[7 * 257]);
            *(u32x4*)(Wt + (size_t)(n0 + n) * K + k0 + 8 * kc) = w; }
    }
    __syncthreads();
}
__device__ __forceinline__ void p0_convert_p(const float* __restrict__ p, bf16_t* __restrict__ pb, int G) {
    const size_t n8 = (size_t)M_TOK * DPLE / 8;
    for (size_t i = (size_t)blockIdx.x * 512 + tidx(); i < n8; i += (size_t)G * 512) { const f32x4 a = *(const f32x4*)(p + i * 8), b = *(const f32x4*)(p + i * 8 + 4);
        u32x4 w; w.x = cvtpk2(a[0], a[1]); w.y = cvtpk2(a[2], a[3]); w.z = cvtpk2(b[0], b[1]); w.w = cvtpk2(b[2], b[3]); *(u32x4*)(pb + i * 8) = w; }
}

constexpr int VT_STRIDE = 136;
__device__ __forceinline__ void p2_gmlp(bf16_t* __restrict__ AU, const bf16_t* __restrict__ AV, const float* __restrict__ lnp, const float* __restrict__ lng, const float* __restrict__ lnb,
                                         const float* __restrict__ ws, const float* __restrict__ bs, int G, LAS unsigned char* lds) {
    const int tid = tidx(), lane = tid & 63, wid = tid >> 6, fr = lane & 15, fq = lane >> 4;
    LAS bf16_t* VT = (LAS bf16_t*)lds; LAS float* ST = (LAS float*)(lds + 128 * VT_STRIDE * 2);
    for (int tile = blockIdx.x; tile < 2048; tile += G) {
        const int g = tile & 15, cn = tile >> 4, T0 = cn * 128;
        if (tid < 128) { const float* pp = lnp + (size_t)(T0 + tid) * 64; float s1 = 0.f, s2 = 0.f;
#pragma unroll
            for (int i = 0; i < 16; ++i) { const f32x4 q = *(const f32x4*)(pp + 4 * i); s1 += q[0] + q[2]; s2 += q[1] + q[3]; }
            const float mean = s1 * (1.0f / WBR), var = s2 * (1.0f / WBR) - mean * mean;
            ST[2 * tid] = mean; ST[2 * tid + 1] = __builtin_amdgcn_rsqf(fmaxf(var, 0.f) + EPS); }
        __syncthreads();
#pragma unroll
        for (int it = 0; it < 4; ++it) { const int idx = it * 512 + tid, s = idx >> 4, ch = (idx & 15) * 8;
            const u32x4 w = *(const u32x4*)(AV + (size_t)(T0 + s) * WBR + g * 128 + ch);
            const float mean = ST[2 * s], rstd = ST[2 * s + 1];
            const f32x4 g0 = *(const f32x4*)(lng + g * 128 + ch), g1 = *(const f32x4*)(lng + g * 128 + ch + 4), b0 = *(const f32x4*)(lnb + g * 128 + ch), b1 = *(const f32x4*)(lnb + g * 128 + ch + 4);
            float v[8] = {bf_lo(w.x), bf_hi(w.x), bf_lo(w.y), bf_hi(w.y), bf_lo(w.z), bf_hi(w.z), bf_lo(w.w), bf_hi(w.w)};
#pragma unroll
            for (int e = 0; e < 8; ++e) { const float gg = e < 4 ? g0[e & 3] : g1[e & 3], bb = e < 4 ? b0[e & 3] : b1[e & 3];
                const float y = (v[e] - mean) * rstd * gg + bb; const unsigned pk = cvtpk2(y, y); VT[(ch + e) * VT_STRIDE + s] = (bf16_t)(pk & 0xffffu); } }
        __syncthreads();
        f32x4 acc[8];
#pragma unroll
        for (int n = 0; n < 8; ++n) acc[n] = (f32x4){0.f, 0.f, 0.f, 0.f};
        const int t = 16 * wid + fr; const float* wrow = ws + ((size_t)g * 128 + t) * 128;
        const int nks = (16 * wid + 15) / 32 + 1;
        for (int ks = 0; ks < nks; ++ks) { const int s0 = 32 * ks + 8 * fq;
            const f32x4 w0 = *(const f32x4*)(wrow + s0), w1 = *(const f32x4*)(wrow + s0 + 4);
            float wv[8] = {w0[0], w0[1], w0[2], w0[3], w1[0], w1[1], w1[2], w1[3]};
#pragma unroll
            for (int e = 0; e < 8; ++e) wv[e] = (s0 + e <= t) ? wv[e] : 0.f;
            u32x4 wp; wp.x = cvtpk2(wv[0], wv[1]); wp.y = cvtpk2(wv[2], wv[3]); wp.z = cvtpk2(wv[4], wv[5]); wp.w = cvtpk2(wv[6], wv[7]);
            const bf16x8 wf = *reinterpret_cast<bf16x8*>(&wp);
#pragma unroll
            for (int n = 0; n < 8; ++n) { const bf16x8 vf = *(const LAS bf16x8*)(VT + (16 * n + fr) * VT_STRIDE + s0);
                acc[n] = __builtin_amdgcn_mfma_f32_16x16x32_bf16(vf, wf, acc[n], 0, 0, 0); } }
        const float bias = bs[g * 128 + t];
#pragma unroll
        for (int n = 0; n < 8; ++n) { bf16_t* pa = AU + (size_t)(T0 + t) * WBR + g * 128 + 16 * n + 4 * fq; const u32x2 a = *(const u32x2*)pa;
            u32x2 o; o.x = cvtpk2(bf_lo(a.x) * (acc[n][0] + bias), bf_hi(a.x) * (acc[n][1] + bias)); o.y = cvtpk2(bf_lo(a.y) * (acc[n][2] + bias), bf_hi(a.y) * (acc[n][3] + bias));
            *(u32x2*)pa = o; }
        __syncthreads();
    }
}

__device__ __forceinline__ void p3_merge(const bf16_t* __restrict__ proj, const bf16_t* __restrict__ OC, const float* __restrict__ lse, const float* __restrict__ ga, const float* __restrict__ gb,
                                          bf16_t* __restrict__ Y, int G) {
    const int lane = tidx() & 63, wid = tidx() >> 6;
    const bf16_t* YA = proj; const bf16_t* AZ = proj + 2 * SEG; const bf16_t* BZ = proj + 6 * SEG;
    for (int row = blockIdx.x * 8 + wid; row < M_TOK; row += G * 8) {
        float va[4][8], vb[4][8]; float ssa = 0.f, ssb = 0.f;
#pragma unroll
        for (int j = 0; j < 4; ++j) { const int c = 8 * (lane + 64 * j); const size_t o = (size_t)row * WBR + c;
            const u32x4 w = *(const u32x4*)(YA + o);
            va[j][0] = bf_lo(w.x); va[j][1] = bf_hi(w.x); va[j][2] = bf_lo(w.y); va[j][3] = bf_hi(w.y); va[j][4] = bf_lo(w.z); va[j][5] = bf_hi(w.z); va[j][6] = bf_lo(w.w); va[j][7] = bf_hi(w.w);
#pragma unroll
            for (int e = 0; e < 8; ++e) ssa += va[j][e] * va[j][e];
            const int h = c >> 7; const float l0 = lse[(size_t)row * 16 + h], l1 = lse[(size_t)(M_TOK + row) * 16 + h], l2 = lse[(size_t)(2 * M_TOK + row) * 16 + h];
            const float mx = fmaxf(l0, fmaxf(l1, l2)); const float e0 = __expf(l0 - mx), e1 = __expf(l1 - mx), e2 = __expf(l2 - mx); const float inv = 1.0f / (e0 + e1 + e2);
            const float a0 = e0 * inv, a1 = e1 * inv, a2 = e2 * inv;
            const u32x4 o0 = *(const u32x4*)(OC + o), o1 = *(const u32x4*)(OC + SEG + o), o2 = *(const u32x4*)(OC + 2 * SEG + o);
            vb[j][0] = a0 * bf_lo(o0.x) + a1 * bf_lo(o1.x) + a2 * bf_lo(o2.x); vb[j][1] = a0 * bf_hi(o0.x) + a1 * bf_hi(o1.x) + a2 * bf_hi(o2.x);
            vb[j][2] = a0 * bf_lo(o0.y) + a1 * bf_lo(o1.y) + a2 * bf_lo(o2.y); vb[j][3] = a0 * bf_hi(o0.y) + a1 * bf_hi(o1.y) + a2 * bf_hi(o2.y);
            vb[j][4] = a0 * bf_lo(o0.z) + a1 * bf_lo(o1.z) + a2 * bf_lo(o2.z); vb[j][5] = a0 * bf_hi(o0.z) + a1 * bf_hi(o1.z) + a2 * bf_hi(o2.z);
            vb[j][6] = a0 * bf_lo(o0.w) + a1 * bf_lo(o1.w) + a2 * bf_lo(o2.w); vb[j][7] = a0 * bf_hi(o0.w) + a1 * bf_hi(o1.w) + a2 * bf_hi(o2.w);
#pragma unroll
            for (int e = 0; e < 8; ++e) ssb += vb[j][e] * vb[j][e]; }
        ssa = wave_sum(ssa); ssb = wave_sum(ssb);
        const float rsa = __builtin_amdgcn_rsqf(ssa * (1.0f / WBR) + EPS), rsb = __builtin_amdgcn_rsqf(ssb * (1.0f / WBR) + EPS);
#pragma unroll
        for (int j = 0; j < 4; ++j) { const int c = 8 * (lane + 64 * j); const size_t o = (size_t)row * WBR + c;
            const u32x4 za = *(const u32x4*)(AZ + o), zb = *(const u32x4*)(BZ + o);
            const f32x4 ga0 = *(const f32x4*)(ga + c), ga1 = *(const f32x4*)(ga + c + 4), gb0 = *(const f32x4*)(gb + c), gb1 = *(const f32x4*)(gb + c + 4);
            u32x4 wa, wb;
            wa.x = cvtpk2(va[j][0] * rsa * ga0[0] * bf_lo(za.x), va[j][1] * rsa * ga0[1] * bf_hi(za.x)); wa.y = cvtpk2(va[j][2] * rsa * ga0[2] * bf_lo(za.y), va[j][3] * rsa * ga0[3] * bf_hi(za.y));
            wa.z = cvtpk2(va[j][4] * rsa * ga1[0] * bf_lo(za.z), va[j][5] * rsa * ga1[1] * bf_hi(za.z)); wa.w = cvtpk2(va[j][6] * rsa * ga1[2] * bf_lo(za.w), va[j][7] * rsa * ga1[3] * bf_hi(za.w));
            wb.x = cvtpk2(vb[j][0] * rsb * gb0[0] * bf_lo(zb.x), vb[j][1] * rsb * gb0[1] * bf_hi(zb.x)); wb.y = cvtpk2(vb[j][2] * rsb * gb0[2] * bf_lo(zb.y), vb[j][3] * rsb * gb0[3] * bf_hi(zb.y));
            wb.z = cvtpk2(vb[j][4] * rsb * gb1[0] * bf_lo(zb.z), vb[j][5] * rsb * gb1[1] * bf_hi(zb.z)); wb.w = cvtpk2(vb[j][6] * rsb * gb1[2] * bf_lo(zb.w), vb[j][7] * rsb * gb1[3] * bf_hi(zb.w));
            *(u32x4*)(Y + (size_t)row * DM + c) = wa; *(u32x4*)(Y + (size_t)row * DM + WBR + c) = wb; }
    }
}
__device__ __forceinline__ att::BlockRef<__hip_bfloat16, __hip_bfloat16> att_ref(int id, const bf16_t* proj, bf16_t* OC, float* lse, const float* relb) {
    const int cfg = id >> 10, rem = id & 1023, bh = rem >> 4, within = rem & 15, b = bh >> 4, h = bh & 15;
    const int dil = cfg == 0 ? 1 : (cfg == 1 ? 4 : 16), nqb = 16 / dil, r = within / nqb, qb = within % nqb;
    const size_t tok0 = (size_t)b * SEQ + r, tokq = tok0 + (size_t)(qb * 256) * dil;
    att::BlockRef<__hip_bfloat16, __hip_bfloat16> R;
    R.Q = (const __hip_bfloat16*)(proj + 3 * SEG + tokq * WBR + h * 128);
    R.K = (const __hip_bfloat16*)(proj + 4 * SEG + tok0 * WBR + h * 128);
    R.V = (const __hip_bfloat16*)(proj + 5 * SEG + tok0 * WBR + h * 128);
    R.O = (__hip_bfloat16*)(OC + (size_t)cfg * SEG + tokq * WBR + h * 128);
    R.LSE = lse + ((size_t)cfg * M_TOK + tokq) * 16 + h; R.RB = relb + h; R.P0 = qb * 256; R.RS = dil * WBR; R.dil = dil;
    return R;
}
__device__ __forceinline__ void p2_attention(const bf16_t* proj, bf16_t* OC, float* lse, const float* relb, int G, char* lds) {
    constexpr int TOTAL = 3072;
    int L = blockIdx.x; if (L >= TOTAL) return;
    typedef att::BlockRef<__hip_bfloat16, __hip_bfloat16> BR;
    BR cur = att_ref(L, proj, OC, lse, relb);
    att::Seam<__hip_bfloat16> S;
    att::causal_swa_prime<__hip_bfloat16, __hip_bfloat16>(cur, 129, lds, S);
    for (;;) {
        const bool last = L + G >= TOTAL;
        const BR nxt = last ? cur : att_ref(L + G, proj, OC, lse, relb);
        att::causal_swa_block<__hip_bfloat16, __hip_bfloat16>(cur, nxt, SEQ / cur.dil, 129, lds, S);
        if (last) break;
        cur = nxt; L += G;
    }
}

__device__ __forceinline__ void grid_barrier(unsigned* ctr, unsigned target) {
    asm volatile("s_waitcnt vmcnt(0) lgkmcnt(0)" ::: "memory");
    __syncthreads();
    if (tidx() == 0) {
        __builtin_amdgcn_fence(__ATOMIC_RELEASE, "agent");
        asm volatile("s_waitcnt vmcnt(0)" ::: "memory");
        __hip_atomic_fetch_add(ctr, 1u, __ATOMIC_RELAXED, __HIP_MEMORY_SCOPE_AGENT);
        while (__hip_atomic_load(ctr, __ATOMIC_RELAXED, __HIP_MEMORY_SCOPE_AGENT) < target) __builtin_amdgcn_s_sleep(2);
        __builtin_amdgcn_fence(__ATOMIC_ACQUIRE, "agent");
        asm volatile("s_waitcnt vmcnt(0)" ::: "memory");
    }
    __syncthreads();
}
struct Params { const float* in[17]; float* out; unsigned char* ws; int ph_lo, ph_hi; };
constexpr int NPHASE = 6;
__global__ void __launch_bounds__(512, 2) hybrid_layer_fwd(Params P) {
    LAS unsigned char* lds = (LAS unsigned char*)lds_raw;
    { const int t0 = (int)__builtin_amdgcn_workitem_id_x(); if ((t0 & 63) == 0) ((LAS int*)(lds + LDS_WTAB))[hw_slot()] = t0 >> 6; __syncthreads(); }
    cg::grid_group grid = cg::this_grid();
    const int G = gridDim.x, lo = P.ph_lo, hi = P.ph_hi;
    unsigned char* ws = P.ws;
    const float* x = P.in[0]; const float* p = P.in[1]; const float* g_pre = P.in[2]; const float* w_in = P.in[3]; const float* w_s = P.in[4]; const float* b_s = P.in[5];
    const float* ln_v_g = P.in[6]; const float* ln_v_b = P.in[7]; const float* g_q = P.in[8]; const float* g_k = P.in[9]; const float* rel_bias = P.in[10];
    const float* g_out_a = P.in[11]; const float* g_out_b = P.in[12]; const float* w_out = P.in[13]; const float* g_ple = P.in[14]; const float* w_gate = P.in[15]; const float* w_up = P.in[16];
    bf16_t* HN = (bf16_t*)(ws + WS_HN); bf16_t* WIN = (bf16_t*)(ws + WS_WIN); bf16_t* WOUT = (bf16_t*)(ws + WS_WOUT); bf16_t* WG = (bf16_t*)(ws + WS_WG); bf16_t* WUP = (bf16_t*)(ws + WS_WUP);
    bf16_t* PB = (bf16_t*)(ws + WS_PB); float* LNP = (float*)(ws + WS_LNP); float* HSQ = (float*)(ws + WS_HSQ); float* LSE = (float*)(ws + WS_LSE);
    bf16_t* PROJ = (bf16_t*)(ws + WS_PROJ); bf16_t* OC = (bf16_t*)(ws + WS_OC); float* H = (float*)(ws + WS_H); bf16_t* HB = (bf16_t*)(ws + WS_HB);
#define IN_PH(k) (lo <= (k) && (k) < hi)
    unsigned* CTL = (unsigned*)(ws + WS_CTL);
#define SEAM(k) do { if (lo <= (k) && (k) + 1 < hi) { if ((k) == 0) grid.sync(); else grid_barrier(CTL + 64 * (k), (unsigned)G); } } while (0)

    if (IN_PH(0)) {
        p0_rmsnorm_x(x, g_pre, HN, G);
        p0_convert_p(p, PB, G);
        LAS float* T = (LAS float*)lds;
        p0_transpose(w_in, nullptr, WIN, DM, DIN, 0, G, T);
        p0_transpose(w_out, nullptr, WOUT, DM, DM, 3584, G, T);
        p0_transpose(w_gate, g_ple, WG, DM, DM, 3584 + 1024, G, T);
        p0_transpose(w_up, nullptr, WUP, DPLE, DM, 3584 + 2048, G, T);
    }
    SEAM(0);
    if (IN_PH(1)) {
        pg8::Gemm g{HN, WIN, M_TOK, DIN, DM}; pg8::StaticOrder S; S.init(M_TOK, DIN, G, (int)blockIdx.x);
        pg8::EpiProj E{PROJ, LNP, g_q, g_k, (LAS float*)(lds + LDS_X)};
        pg8::gemm_phase<pg8::EpiProj, pg8::StaticOrder>(lds, g, S, E, nullptr);
    }
    SEAM(1);
    if (IN_PH(2)) {
        p2_gmlp(PROJ, PROJ + SEG, LNP, ln_v_g, ln_v_b, w_s, b_s, G, lds);
        p2_attention(PROJ, OC, LSE, rel_bias, G, (char*)lds_raw);
    }
    SEAM(2);
    if (IN_PH(3)) p3_merge(PROJ, OC, LSE, g_out_a, g_out_b, HN, G);
    SEAM(3);
    if (IN_PH(4)) {
        pg8::Gemm g{HN, WOUT, M_TOK, DM, DM}; pg8::StaticOrder S; S.init(M_TOK, DM, G, (int)blockIdx.x);
        pg8::EpiH E{x, H, HB, HSQ};
        pg8::gemm_phase<pg8::EpiH, pg8::StaticOrder>(lds, g, S, E, nullptr);
    }
    SEAM(4);
    if (IN_PH(5)) {
        { pg8::Gemm g{PB, WUP, M_TOK, DM, DPLE}; pg8::StaticOrder S; S.init(M_TOK, DM, G, (int)blockIdx.x);
          pg8::EpiU E{P.out};
          pg8::gemm_phase<pg8::EpiU, pg8::StaticOrder>(lds, g, S, E, nullptr); }
        { pg8::Gemm g{HB, WG, M_TOK, DM, DM}; pg8::RsOrder S; S.init(M_TOK, DM, G, (int)blockIdx.x); S.hsq = HSQ; S.RS = (LAS float*)(lds + LDS_RS);
          pg8::EpiOut E{H, P.out, (LAS float*)(lds + LDS_RS)};
          pg8::gemm_phase<pg8::EpiOut, pg8::RsOrder>(lds, g, S, E, nullptr); }
    }
#undef IN_PH
#undef SEAM
}

#ifndef MK_LAUNCHES
#define MK_LAUNCHES 1
#endif
extern "C" void kernel_launch(void* const* d_in, const int* in_sizes, int n_in, void* d_out, int out_size, void* d_ws, size_t ws_size, hipStream_t stream) {
    static int grid = 0;
    if (grid == 0) {
        if (n_in != 17 || out_size != M_TOK * DM || ws_size < WS_END) { fprintf(stderr, "kernel_launch: unexpected shapes (n_in %d out %d ws %zu)\n", n_in, out_size, ws_size); grid = -1; return; }
        if (hipFuncSetAttribute((const void*)hybrid_layer_fwd, hipFuncAttributeMaxDynamicSharedMemorySize, LDS_BYTES) != hipSuccess) { fprintf(stderr, "kernel_launch: hipFuncSetAttribute failed\n"); grid = -1; return; }
        int dev = 0, cus = 0, per_cu = 0;
        (void)hipGetDevice(&dev); (void)hipDeviceGetAttribute(&cus, hipDeviceAttributeMultiprocessorCount, dev);
        if (hipOccupancyMaxActiveBlocksPerMultiprocessor(&per_cu, (const void*)hybrid_layer_fwd, 512, LDS_BYTES) != hipSuccess || per_cu < 1) { fprintf(stderr, "kernel_launch: occupancy query says %d blocks/CU\n", per_cu); per_cu = 1; }
        (void)hipGetLastError();
        grid = cus > 0 ? cus : 256;
    }
    if (grid < 0) return;
    (void)hipMemsetAsync((unsigned char*)d_ws + WS_CTL, 0, 4096, stream);
    Params P{};
    for (int i = 0; i < 17; ++i) P.in[i] = (const float*)d_in[i];
    P.out = (float*)d_out; P.ws = (unsigned char*)d_ws;
#if MK_LAUNCHES == 1
    P.ph_lo = 0; P.ph_hi = NPHASE;
    void* args[] = {&P};
    hipError_t e = hipLaunchCooperativeKernel((const void*)hybrid_layer_fwd, dim3(grid), dim3(512), args, LDS_BYTES, stream);
    if (e != hipSuccess) fprintf(stderr, "kernel_launch: cooperative launch failed: %s (grid %d)\n", hipGetErrorString(e), grid);
#else
    for (int ph = 0; ph < NPHASE; ++ph) { P.ph_lo = ph; P.ph_hi = ph + 1;
        hipLaunchKernelGGL(hybrid_layer_fwd, dim3(grid), dim3(512), LDS_BYTES, stream, P); }
#endif
}
```

```cpp
#include <hip/hip_runtime.h>
#include <hip/hip_bf16.h>
#include <hip/hip_cooperative_groups.h>
#include <cstdio>
#include <cstdint>
namespace cg = cooperative_groups;
#define LAS __attribute__((address_space(3)))

constexpr int M_TOK = 16384, DM = 4096, DIN = 14336, WBR = 2048, SEQ = 4096, NBATCH = 4, NHEAD = 16, DPLE = 256;
constexpr float EPS = 1e-6f;
constexpr size_t MiB = 1024ull * 1024ull;
constexpr size_t WS_HN = 0;
constexpr size_t WS_WIN = 128 * MiB;
constexpr size_t WS_WOUT = 240 * MiB;
constexpr size_t WS_WG = 272 * MiB;
constexpr size_t WS_WUP = 304 * MiB;
constexpr size_t WS_PB = 306 * MiB;
constexpr size_t WS_LNP = 314 * MiB;
constexpr size_t WS_HSQ = 318 * MiB;
constexpr size_t WS_LSE = 322 * MiB;
constexpr size_t WS_CTL = 326 * MiB;
constexpr size_t WS_PROJ = 330 * MiB;
constexpr size_t WS_OC = 778 * MiB;
constexpr size_t WS_HB = 330 * MiB;
constexpr size_t WS_UB = 458 * MiB;
constexpr size_t WS_END = 970 * MiB;
constexpr size_t SEG = (size_t)M_TOK * WBR;
constexpr int LDS_STAGE = 131072, LDS_X = 131072  , LDS_RS = LDS_X + 8192  , LDS_WTAB = 156160  , LDS_XB = LDS_WTAB + 256  , LDS_BYTES = LDS_XB + 16;
extern __shared__ __attribute__((aligned(16))) unsigned char lds_raw[];
__device__ __forceinline__ int hw_slot() { unsigned v; asm volatile("s_getreg_b32 %0, hwreg(HW_REG_HW_ID, 0, 6)" : "=s"(v)); return (int)v; }
__device__ __forceinline__ int tidx() {
    const int w = __builtin_amdgcn_readfirstlane(((const LAS int*)((LAS unsigned char*)lds_raw + LDS_WTAB))[hw_slot()]);
    unsigned l; asm volatile("v_mbcnt_lo_u32_b32 %0, -1, 0\n\tv_mbcnt_hi_u32_b32 %0, -1, %0" : "=v"(l));
    return w * 64 + (int)l;
}
namespace pg8 {
#define PG8_LAS __attribute__((address_space(3)))
typedef unsigned short bf16_t;
typedef short bf16x8 __attribute__((ext_vector_type(8)));
typedef float f32x4 __attribute__((ext_vector_type(4)));
typedef unsigned u32x4 __attribute__((ext_vector_type(4)));
constexpr int BM = 256, BK = 64, HALF = 128, HTB = HALF * BK * 2  , STAGE_BYTES = 8 * HTB, NXCD = 8, WGM = 8;

__host__ __device__ __forceinline__ int lds_byte(int r, int c) { const int st = (r >> 4) * 2 + (c >> 5), rr = r & 15, cc = c & 31, ob = rr * 64 + cc * 2; return st * 1024 + (ob ^ (((ob >> 9) & 1) << 5)); }
__host__ __device__ __forceinline__ void stage_rc(int b, int& R, int& C) { const int st = b / 1024, sb = b % 1024, swz = sb ^ (((sb >> 9) & 1) << 5); R = (st >> 1) * 16 + swz / 64; C = (st & 1) * 32 + (swz % 64) / 2; }
__host__ __device__ __forceinline__ int perm32(int rho) { const int n = rho >> 4, i = rho & 15; return 8 * (i >> 2) + 4 * n + (i & 3); }

struct Unit { int pm, pn; };
struct Gemm { const bf16_t* A; const bf16_t* Bt; int M, N, K; };

struct StaticOrder {
    int nM, nN, nwg, G, c;
    __host__ __device__ void init(int M, int N, int G_, int c_) { nM = M / BM; nN = N / BM; nwg = nM * nN; G = G_; c = c_; }
    __host__ __device__ bool next(int i, Unit& u) const {
        const long L = (long)i * G + c; if (L >= nwg) return false;
        int wgid = (int)L; { const int q = nwg / NXCD, r = nwg % NXCD, xcd = wgid % NXCD, off = wgid / NXCD; wgid = (xcd < r ? xcd * (q + 1) : r * (q + 1) + (xcd - r) * q) + off; }
        const int nig = WGM * nN, gid = wgid / nig, fm = gid * WGM, gsz = (nM - fm) < WGM ? (nM - fm) : WGM;
        u.pm = fm + ((wgid % nig) % gsz); u.pn = (wgid % nig) / gsz; return true;
    }
    __device__ __forceinline__ void a_ready(const Unit&, int) const {}
    __device__ __forceinline__ void done(const Unit&) const {}
};
}
namespace pg8 {
__device__ __forceinline__ unsigned cvt_pk_bf16(float lo, float hi) { unsigned r; asm volatile("v_cvt_pk_bf16_f32 %0, %1, %2" : "=v"(r) : "v"(lo), "v"(hi)); return r; }
typedef float f32x2 __attribute__((ext_vector_type(2)));
__device__ __forceinline__ f32x2 gelu_pk(f32x2 v) {
    const f32x2 av = __builtin_elementwise_abs(v), d = av * 0.2316418882f + 1.0f;
    f32x2 t; t.x = __builtin_amdgcn_rcpf(d.x); t.y = __builtin_amdgcn_rcpf(d.y);
    f32x2 q = t * 0.5307027145f + (-0.7265760135f); q = q * t + 0.7107068705f; q = q * t + (-0.142248368f); q = q * t + 0.127414796f; q = q * t;
    const f32x2 s = (v * v) * (-0.72134752044f);
    f32x2 e; e.x = __builtin_amdgcn_exp2f(s.x); e.y = __builtin_amdgcn_exp2f(s.y);
    const f32x2 m = v * (q * e), r = v - m;
    f32x2 o; o.x = v.x < 0.f ? m.x : r.x; o.y = v.y < 0.f ? m.y : r.y; return o;
}
}
namespace pg8 {
__device__ __forceinline__ float sigmoidf_(float v) { return __builtin_amdgcn_rcpf(1.0f + __builtin_amdgcn_exp2f(-1.4426950408889634f * v)); }
__device__ __forceinline__ f32x4 gelu4(f32x4 v) { const f32x2 a = gelu_pk((f32x2){v[0], v[1]}), b = gelu_pk((f32x2){v[2], v[3]}); return (f32x4){a.x, a.y, b.x, b.y}; }
__device__ __forceinline__ f32x4 silu4(f32x4 v) { return (f32x4){v[0] * sigmoidf_(v[0]), v[1] * sigmoidf_(v[1]), v[2] * sigmoidf_(v[2]), v[3] * sigmoidf_(v[3])}; }
__device__ __forceinline__ float sq4(f32x4 v) { return (v[0] * v[0] + v[1] * v[1]) + (v[2] * v[2] + v[3] * v[3]); }
__device__ __forceinline__ float sum4(f32x4 v) { return (v[0] + v[1]) + (v[2] + v[3]); }

struct EpiProj {
    static constexpr bool PERM = true, AFTER_DRAIN = false;
    bf16_t* proj; float* lnp; const float* gq; const float* gk; PG8_LAS float* X;
    __device__ __forceinline__ void operator()(const f32x4 (&acc)[2][2][4][2], const Unit& u, int ui, int wr, int wc, int fr, int fq) const {
        const int seg = __builtin_amdgcn_readfirstlane(u.pn >> 3), ct = __builtin_amdgcn_readfirstlane(u.pn & 7);
        const int row0 = u.pm * BM + wr * 64 + fr, col0 = ct * 256 + wc * 64 + 8 * fq;
        bf16_t* base = proj + (size_t)seg * SEG;
        if (seg == 3 || seg == 4) {
#pragma unroll
            for (int ai = 0; ai < 2; ++ai)
#pragma unroll
                for (int m = 0; m < 4; ++m)
#pragma unroll
                    for (int bj = 0; bj < 2; ++bj) {
                        float s = sq4(acc[ai][bj][m][0]) + sq4(acc[ai][bj][m][1]);
                        s += __shfl_xor(s, 16); s += __shfl_xor(s, 32);
                        if (fq == 0) X[((ai * HALF + wr * 64 + m * 16 + fr) * 2 + (wc >> 1)) * 4 + (wc & 1) * 2 + bj] = s;
                    }
            asm volatile("s_waitcnt lgkmcnt(0)" ::: "memory"); __builtin_amdgcn_s_barrier(); asm volatile("" ::: "memory");
            const float* gv = (seg == 3 ? gq : gk) + (wc & 1) * 64 + 8 * fq;
            const f32x4 g00 = *(const f32x4*)gv, g01 = *(const f32x4*)(gv + 4), g10 = *(const f32x4*)(gv + 32), g11 = *(const f32x4*)(gv + 36);
            const float sc = seg == 3 ? 0.08838834764831845f : 1.0f;
#pragma unroll
            for (int ai = 0; ai < 2; ++ai)
#pragma unroll
                for (int m = 0; m < 4; ++m) { bf16_t* rowp = base + (size_t)(row0 + ai * HALF + m * 16) * WBR + col0;
#pragma unroll
                    for (int bj = 0; bj < 2; ++bj) {
                        const f32x4 p = *(const PG8_LAS f32x4*)(X + ((ai * HALF + wr * 64 + m * 16 + fr) * 2 + (wc >> 1)) * 4);
                        const float rs = __builtin_amdgcn_rsqf(((p[0] + p[1]) + (p[2] + p[3])) * (1.0f / 128.0f) + EPS) * sc;
                        const f32x4 v0 = acc[ai][bj][m][0] * rs * (bj ? g10 : g00), v1 = acc[ai][bj][m][1] * rs * (bj ? g11 : g01);
                        u32x4 w; w.x = cvt_pk_bf16(v0[0], v0[1]); w.y = cvt_pk_bf16(v0[2], v0[3]); w.z = cvt_pk_bf16(v1[0], v1[1]); w.w = cvt_pk_bf16(v1[2], v1[3]);
                        *(u32x4*)(rowp + bj * 32) = w; } }
        } else {
#pragma unroll
            for (int ai = 0; ai < 2; ++ai)
#pragma unroll
                for (int m = 0; m < 4; ++m) { bf16_t* rowp = base + (size_t)(row0 + ai * HALF + m * 16) * WBR + col0; float s1 = 0.f, s2 = 0.f;
#pragma unroll
                    for (int bj = 0; bj < 2; ++bj) { f32x4 v0 = acc[ai][bj][m][0], v1 = acc[ai][bj][m][1];
                        if (seg == 1) { v0 = gelu4(v0); v1 = gelu4(v1); }
                        if (seg == 1) { s1 += sum4(v0) + sum4(v1); s2 += sq4(v0) + sq4(v1); }
                        u32x4 w; w.x = cvt_pk_bf16(v0[0], v0[1]); w.y = cvt_pk_bf16(v0[2], v0[3]); w.z = cvt_pk_bf16(v1[0], v1[1]); w.w = cvt_pk_bf16(v1[2], v1[3]);
                        if (seg == 5) *(u32x4*)(rowp + bj * 32) = w; else __builtin_nontemporal_store(w, (u32x4*)(rowp + bj * 32)); }
                    if (seg == 1) { s1 += __shfl_xor(s1, 16); s1 += __shfl_xor(s1, 32); s2 += __shfl_xor(s2, 16); s2 += __shfl_xor(s2, 32);
                        if (fq == 0) *(f32x2*)(lnp + ((size_t)(row0 + ai * HALF + m * 16) * 32 + ct * 4 + wc) * 2) = (f32x2){s1, s2}; } }
        }
    }
};
struct EpiNull {
    static constexpr bool PERM = true, AFTER_DRAIN = false;
    float* sink;
    __device__ __forceinline__ void operator()(const f32x4 (&acc)[2][2][4][2], const Unit& u, int ui, int wr, int wc, int fr, int fq) const {
        float s = 0.f;
#pragma unroll
        for (int ai = 0; ai < 2; ++ai)
#pragma unroll
            for (int bj = 0; bj < 2; ++bj)
#pragma unroll
                for (int m = 0; m < 4; ++m)
#pragma unroll
                    for (int n = 0; n < 2; ++n) s += sum4(acc[ai][bj][m][n]);
        if (s == 123.456f) sink[0] = s;
    }
};
struct EpiH {
    static constexpr bool PERM = true, AFTER_DRAIN = false;
    const float* x; bf16_t* HB; float* hsq;
    __device__ __forceinline__ void operator()(const f32x4 (&acc)[2][2][4][2], const Unit& u, int ui, int wr, int wc, int fr, int fq) const {
        const int row0 = u.pm * BM + wr * 64 + fr, col0 = u.pn * BM + wc * 64 + 8 * fq;
#pragma unroll
        for (int ai = 0; ai < 2; ++ai)
#pragma unroll
            for (int m = 0; m < 4; ++m) { const int row = row0 + ai * HALF + m * 16; const size_t off = (size_t)row * DM + col0; float s = 0.f;
#pragma unroll
                for (int bj = 0; bj < 2; ++bj) { const f32x4 h0 = *(const f32x4*)(x + off + bj * 32) + acc[ai][bj][m][0], h1 = *(const f32x4*)(x + off + bj * 32 + 4) + acc[ai][bj][m][1];
                    s += sq4(h0) + sq4(h1);
                    u32x4 w; w.x = cvt_pk_bf16(h0[0], h0[1]); w.y = cvt_pk_bf16(h0[2], h0[3]); w.z = cvt_pk_bf16(h1[0], h1[1]); w.w = cvt_pk_bf16(h1[2], h1[3]);
                    *(u32x4*)(HB + off + bj * 32) = w; }
                s += __shfl_xor(s, 16); s += __shfl_xor(s, 32);
                if (fq == 0) hsq[(size_t)row * 64 + u.pn * 4 + wc] = s;
                if (m == 3) asm volatile("" ::: "memory"); }
    }
};
struct EpiU {
    static constexpr bool PERM = true, AFTER_DRAIN = false;
    bf16_t* U;
    __device__ __forceinline__ void operator()(const f32x4 (&acc)[2][2][4][2], const Unit& u, int ui, int wr, int wc, int fr, int fq) const {
        const int row0 = u.pm * BM + wr * 64 + fr, col0 = u.pn * BM + wc * 64 + 8 * fq;
#pragma unroll
        for (int ai = 0; ai < 2; ++ai)
#pragma unroll
            for (int m = 0; m < 4; ++m) { bf16_t* rowp = U + (size_t)(row0 + ai * HALF + m * 16) * DM + col0;
#pragma unroll
                for (int bj = 0; bj < 2; ++bj) { const f32x4 a = acc[ai][bj][m][0], b = acc[ai][bj][m][1];
                    u32x4 w; w.x = cvt_pk_bf16(a[0], a[1]); w.y = cvt_pk_bf16(a[2], a[3]); w.z = cvt_pk_bf16(b[0], b[1]); w.w = cvt_pk_bf16(b[2], b[3]);
                    __builtin_nontemporal_store(w, (u32x4*)(rowp + bj * 32)); } }
    }
};
struct EpiOut {
    static constexpr bool PERM = true, AFTER_DRAIN = false;
    const bf16_t* HB; const bf16_t* U; float* out; PG8_LAS float* RS;
    __device__ __forceinline__ void operator()(const f32x4 (&acc)[2][2][4][2], const Unit& u, int ui, int wr, int wc, int fr, int fq) const {
        const int row0 = u.pm * BM + wr * 64 + fr, col0 = u.pn * BM + wc * 64 + 8 * fq;
#pragma unroll
        for (int ai = 0; ai < 2; ++ai)
#pragma unroll
            for (int m = 0; m < 4; ++m) { const size_t off = (size_t)(row0 + ai * HALF + m * 16) * DM + col0; const float rs = RS[(ui & 1) * 256 + ai * HALF + wr * 64 + m * 16 + fr];
#pragma unroll
                for (int bj = 0; bj < 2; ++bj) { const u32x4 hw = *(const u32x4*)(HB + off + bj * 32), uw = *(const u32x4*)(U + off + bj * 32);
                    const f32x4 a = acc[ai][bj][m][0] * rs, b = acc[ai][bj][m][1] * rs; f32x4 o0, o1;
                    o0[0] = __uint_as_float(hw.x << 16) + sigmoidf_(a[0]) * __uint_as_float(uw.x << 16); o0[1] = __uint_as_float(hw.x & 0xffff0000u) + sigmoidf_(a[1]) * __uint_as_float(uw.x & 0xffff0000u);
                    o0[2] = __uint_as_float(hw.y << 16) + sigmoidf_(a[2]) * __uint_as_float(uw.y << 16); o0[3] = __uint_as_float(hw.y & 0xffff0000u) + sigmoidf_(a[3]) * __uint_as_float(uw.y & 0xffff0000u);
                    o1[0] = __uint_as_float(hw.z << 16) + sigmoidf_(b[0]) * __uint_as_float(uw.z << 16); o1[1] = __uint_as_float(hw.z & 0xffff0000u) + sigmoidf_(b[1]) * __uint_as_float(uw.z & 0xffff0000u);
                    o1[2] = __uint_as_float(hw.w << 16) + sigmoidf_(b[2]) * __uint_as_float(uw.w << 16); o1[3] = __uint_as_float(hw.w & 0xffff0000u) + sigmoidf_(b[3]) * __uint_as_float(uw.w & 0xffff0000u);
                    __builtin_nontemporal_store(o0, (f32x4*)(out + off + bj * 32)); __builtin_nontemporal_store(o1, (f32x4*)(out + off + bj * 32 + 4)); }
                if (m == 3) asm volatile("" ::: "memory"); }
    }
};
struct SameUnitOrder {
    int n;
    __device__ __forceinline__ bool next(int i, Unit& u) const { if (i >= n) return false; u.pm = 0; u.pn = 0; return true; }
    __device__ __forceinline__ void a_ready(const Unit&, int) const {}
    __device__ __forceinline__ void done(const Unit&) const {}
};
struct RsOrder : StaticOrder {
    const float* hsq; PG8_LAS float* RS;
    __device__ __forceinline__ void a_ready(const Unit& u, int ui) const {
        const int row = tidx() >> 1, half = tidx() & 1; const float* p = hsq + (size_t)(u.pm * BM + row) * 64 + half * 32; float s = 0.f;
#pragma unroll
        for (int i = 0; i < 8; ++i) s += sum4(*(const f32x4*)(p + 4 * i));
        s += __shfl_xor(s, 1);
        if (half == 0) RS[(ui & 1) * 256 + row] = __builtin_amdgcn_rsqf(s * (1.0f / 4096.0f) + EPS);
    }
};
}
namespace pg8 {
#ifndef PG8_ALIGN_EPI
#define PG8_ALIGN_EPI 1
#endif
#ifndef PG8_SP2
#define PG8_SP2 1
#endif
template <class Epi, class Sched, bool STAMP = false>
__device__ __forceinline__ void gemm_phase(PG8_LAS unsigned char* lds, const Gemm g, const Sched& S, const Epi& E, unsigned long long* stamps) {
    const int tid = tidx(), wid = __builtin_amdgcn_readfirstlane(tid >> 6), lane = tid & 63, wr = wid >> 2, wc = wid & 3, fr = lane & 15, fq = lane >> 4;
    const int K = g.K, nt = K / BK; constexpr bool ALIGN_EPI = PG8_ALIGN_EPI != 0, SP2 = PG8_SP2 != 0;
    int ts_lo = 0, ts_hi = 0, nts = 0; const unsigned long long rt_entry = STAMP ? (unsigned long long)wall_clock64() : 0ull;
#define PG8_STAMP() do { if (STAMP && wid == 0 && nts < 64) { const unsigned long long _c = (unsigned long long)clock64(); \
        ts_lo = (lane == nts) ? (int)(unsigned)_c : ts_lo; ts_hi = (lane == nts) ? (int)(unsigned)(_c >> 32) : ts_hi; ++nts; } } while (0)
    PG8_STAMP();
    unsigned voffA[2], voffB0[2];
#pragma unroll
    for (int i = 0; i < 2; ++i) { int R, C; stage_rc(tid * 16 + i * 8192, R, C);
        voffA[i] = (unsigned)(R * K + C) * 2u;
        if (Epi::PERM) { const int Rb = 64 * (R >> 5) + perm32(R & 31);
            voffB0[i] = (unsigned)(Rb * K + C) * 2u; }
        else { voffB0[i] = (unsigned)(R * K + C) * 2u; } }
    const size_t kstep = (size_t)(BK * 2);
    const size_t hstep = (size_t)HALF * K * 2;
    const size_t tstep = 2 * hstep;
    const size_t bh1 = Epi::PERM ? (size_t)32 * K * 2 : hstep;
    const unsigned ldsw = (unsigned)wid * 1024u;
    const int aoff = lds_byte(wr * 64 + fr, fq * 8), boff = lds_byte(wc * 32 + fr, fq * 8);
#define PG8_SA(b, h) (((b) * 2 + (h)) * HTB)
#define PG8_SB(b, h) ((4 + (b) * 2 + (h)) * HTB)
#define PG8_STAGE(bufoff, gbase, voff) do { _Pragma("unroll") for (int _i = 0; _i < 2; ++_i) \
        __builtin_amdgcn_global_load_lds((const unsigned*)((const char*)(gbase) + (voff)[_i]), (PG8_LAS unsigned*)(lds + (bufoff) + ldsw + _i * 8192), 16, 0, 0); } while (0)
#define PG8_LDA(dst, b, h) do { _Pragma("unroll") for (int m = 0; m < 4; ++m) _Pragma("unroll") for (int k = 0; k < 2; ++k) dst[m][k] = *(const PG8_LAS bf16x8*)(lds + PG8_SA(b, h) + aoff + m * 2048 + k * 1024); } while (0)
#define PG8_LDB(dst, b, h) do { _Pragma("unroll") for (int n = 0; n < 2; ++n) _Pragma("unroll") for (int k = 0; k < 2; ++k) dst[n][k] = *(const PG8_LAS bf16x8*)(lds + PG8_SB(b, h) + boff + n * 2048 + k * 1024); } while (0)
#define PG8_MMA(ai, bj, At, Bt) do { __builtin_amdgcn_s_setprio(1); _Pragma("unroll") for (int m = 0; m < 4; ++m) _Pragma("unroll") for (int n = 0; n < 2; ++n) _Pragma("unroll") for (int k = 0; k < 2; ++k) \
        acc[ai][bj][m][n] = __builtin_amdgcn_mfma_f32_16x16x32_bf16(Bt[n][k], At[m][k], acc[ai][bj][m][n], 0, 0, 0); __builtin_amdgcn_s_setprio(0); } while (0)
#define PG8_WAIT_V(n) asm volatile("s_waitcnt vmcnt(" #n ")" ::: "memory")
#define PG8_WAIT_L(n) asm volatile("s_waitcnt lgkmcnt(" #n ")" ::: "memory")
#define PG8_BAR __builtin_amdgcn_s_barrier()
#define PG8_SCHED __builtin_amdgcn_sched_barrier(0)
    Unit cur, nxt; int ui = 0;
    if (!S.next(0, cur)) return;
    f32x4 acc[2][2][4][2];
#pragma unroll
    for (int a = 0; a < 2; ++a)
#pragma unroll
        for (int b = 0; b < 2; ++b)
#pragma unroll
            for (int m = 0; m < 4; ++m)
#pragma unroll
                for (int n = 0; n < 2; ++n) acc[a][b][m][n] = (f32x4){0.f, 0.f, 0.f, 0.f};
    bf16x8 At[4][2], B0[2][2], B1[2][2];
    const char* cA = (const char*)g.A + (size_t)cur.pm * tstep; const char* cB = (const char*)g.Bt + (size_t)cur.pn * tstep;
    S.a_ready(cur, 0);
    if constexpr (SP2) {
        PG8_STAGE(PG8_SB(0, 0), cB, voffB0); PG8_STAGE(PG8_SB(0, 1), cB + bh1, voffB0); PG8_STAGE(PG8_SA(0, 0), cA, voffA); PG8_STAGE(PG8_SA(0, 1), cA + hstep, voffA);
        if (wr == 1) PG8_BAR;
        PG8_WAIT_V(2); PG8_BAR;
        PG8_STAGE(PG8_SB(1, 0), cB + kstep, voffB0); PG8_STAGE(PG8_SA(1, 0), cA + kstep, voffA); PG8_STAGE(PG8_SB(1, 1), cB + kstep + bh1, voffB0);
        PG8_WAIT_V(6); PG8_BAR;
    } else {
    PG8_STAGE(PG8_SB(0, 0), cB, voffB0); PG8_STAGE(PG8_SA(0, 0), cA, voffA); PG8_STAGE(PG8_SB(0, 1), cB + bh1, voffB0); PG8_STAGE(PG8_SA(0, 1), cA + hstep, voffA);
    if (wr == 1) PG8_BAR;
    PG8_WAIT_V(4); PG8_BAR;
    PG8_STAGE(PG8_SB(1, 0), cB + kstep, voffB0); PG8_STAGE(PG8_SA(1, 0), cA + kstep, voffA); PG8_STAGE(PG8_SB(1, 1), cB + kstep + bh1, voffB0);
    PG8_WAIT_V(6); PG8_BAR;
    }
    PG8_STAMP();
    for (;;) {
        const bool has_next = S.next(ui + 1, nxt);
        const char* nA = has_next ? (const char*)g.A + (size_t)nxt.pm * tstep : cA; const char* nB = has_next ? (const char*)g.Bt + (size_t)nxt.pn * tstep : cB;
        for (int t = 0; t < nt; t += 2) {
            const bool last = (t == nt - 2);
            const char* a1 = cA + (size_t)(t + 1) * kstep;
            const char* a2 = last ? nA : cA + (size_t)(t + 2) * kstep; const char* b2 = last ? nB : cB + (size_t)(t + 2) * kstep;
            const char* a3 = a2 + kstep; const char* b3 = b2 + kstep;
            if (last && has_next) S.a_ready(nxt, ui + 1);
            if constexpr (SP2) {
            PG8_LDB(B0, 0, 0); PG8_LDB(B1, 0, 1); PG8_SCHED; PG8_LDA(At, 0, 0); PG8_STAGE(PG8_SA(1, 1), a1 + hstep, voffA);
            PG8_WAIT_V(8); PG8_WAIT_L(0); PG8_BAR; PG8_MMA(0, 0, At, B0); PG8_MMA(0, 1, At, B1); PG8_BAR; PG8_SCHED;
            PG8_LDA(At, 0, 1); PG8_STAGE(PG8_SB(0, 0), b2, voffB0); PG8_STAGE(PG8_SB(0, 1), b2 + bh1, voffB0); PG8_STAGE(PG8_SA(0, 0), a2, voffA);
            PG8_WAIT_V(8); PG8_WAIT_L(0); PG8_BAR; PG8_MMA(1, 0, At, B0); PG8_MMA(1, 1, At, B1); PG8_BAR; PG8_SCHED;
            PG8_LDB(B0, 1, 0); PG8_LDB(B1, 1, 1); PG8_SCHED; PG8_LDA(At, 1, 0); PG8_STAGE(PG8_SA(0, 1), a2 + hstep, voffA);
            PG8_WAIT_V(8); PG8_WAIT_L(0); PG8_BAR; PG8_MMA(0, 0, At, B0); PG8_MMA(0, 1, At, B1); PG8_BAR; PG8_SCHED;
            PG8_LDA(At, 1, 1); PG8_STAGE(PG8_SB(1, 0), b3, voffB0); PG8_STAGE(PG8_SB(1, 1), b3 + bh1, voffB0); PG8_STAGE(PG8_SA(1, 0), a3, voffA);
            PG8_WAIT_V(8); PG8_WAIT_L(0); PG8_BAR; PG8_MMA(1, 0, At, B0); PG8_MMA(1, 1, At, B1); PG8_BAR; PG8_SCHED;
            } else {
            PG8_LDB(B0, 0, 0); PG8_SCHED; PG8_LDA(At, 0, 0); PG8_STAGE(PG8_SA(1, 1), a1 + hstep, voffA);
            PG8_WAIT_L(8); PG8_BAR; PG8_WAIT_L(0); PG8_MMA(0, 0, At, B0); PG8_BAR; PG8_SCHED;
            PG8_LDB(B1, 0, 1); PG8_STAGE(PG8_SB(0, 0), b2, voffB0);
            PG8_BAR; PG8_WAIT_L(0); PG8_MMA(0, 1, At, B1); PG8_BAR;
            PG8_LDA(At, 0, 1); PG8_STAGE(PG8_SA(0, 0), a2, voffA);
            PG8_BAR; PG8_WAIT_L(0); PG8_MMA(1, 0, At, B0); PG8_BAR; PG8_SCHED;
            PG8_STAGE(PG8_SB(0, 1), b2 + bh1, voffB0);
            PG8_WAIT_V(6); PG8_BAR; PG8_MMA(1, 1, At, B1); PG8_BAR;
            PG8_LDB(B0, 1, 0); PG8_SCHED; PG8_LDA(At, 1, 0); PG8_STAGE(PG8_SA(0, 1), a2 + hstep, voffA);
            PG8_WAIT_L(8); PG8_BAR; PG8_WAIT_L(0); PG8_MMA(0, 0, At, B0); PG8_BAR; PG8_SCHED;
            PG8_LDB(B1, 1, 1); PG8_STAGE(PG8_SB(1, 0), b3, voffB0);
            PG8_BAR; PG8_WAIT_L(0); PG8_MMA(0, 1, At, B1); PG8_BAR;
            PG8_LDA(At, 1, 1); PG8_STAGE(PG8_SA(1, 0), a3, voffA);
            PG8_BAR; PG8_WAIT_L(0); PG8_MMA(1, 0, At, B0); PG8_BAR; PG8_SCHED;
            PG8_STAGE(PG8_SB(1, 1), b3 + bh1, voffB0);
            PG8_WAIT_V(6); PG8_BAR; PG8_MMA(1, 1, At, B1); PG8_BAR;
            }
        }
        PG8_STAMP();
        if constexpr (ALIGN_EPI) { if (wr == 0) PG8_BAR; }
        if constexpr (!Epi::AFTER_DRAIN) { E(acc, cur, ui, wr, wc, fr, fq); S.done(cur); }
        PG8_STAMP();
        if (!has_next) break;
#pragma unroll
        for (int a = 0; a < 2; ++a)
#pragma unroll
            for (int b = 0; b < 2; ++b)
#pragma unroll
                for (int m = 0; m < 4; ++m)
#pragma unroll
                    for (int n = 0; n < 2; ++n) acc[a][b][m][n] = (f32x4){0.f, 0.f, 0.f, 0.f};
        cur = nxt; cA = nA; cB = nB; ++ui;
        if constexpr (ALIGN_EPI) { if (wr == 1) PG8_BAR; }
    }
    PG8_WAIT_V(0);
    if constexpr (!ALIGN_EPI) { if (wr == 0) PG8_BAR; }
    PG8_BAR;
    if constexpr (Epi::AFTER_DRAIN) { E.fused(acc, cur, wr, wc, fr, fq, lds, wid, lane); S.done(cur); }
    PG8_STAMP();
    if (STAMP && wid == 0) { stamps[lane] = lane < nts ? (((unsigned long long)(unsigned)ts_hi << 32) | (unsigned)ts_lo) : 0ull;
        if (lane == 62) stamps[62] = rt_entry; if (lane == 63) stamps[63] = (unsigned long long)wall_clock64(); }
#undef PG8_STAMP
#undef PG8_SA
#undef PG8_SB
#undef PG8_STAGE
#undef PG8_LDA
#undef PG8_LDB
#undef PG8_MMA
#undef PG8_WAIT_V
#undef PG8_WAIT_L
#undef PG8_BAR
#undef PG8_SCHED
}
}
namespace att {
constexpr int D = 128; constexpr float THR = 8.f; constexpr bool WSKIP = true;
constexpr float SCALE = 1.0f;
constexpr int NW = 8, QBLK = 32, KVBLK = 64, QB = NW * QBLK;
constexpr int SHM_V = KVBLK * D * 2, SHM_K = KVBLK * D * 2;
constexpr int LDS_BYTES = 2 * SHM_V + 2 * SHM_K + NW * 64 * 4;
constexpr int BT_OFF = LDS_BYTES, BT_N = 320, BT_ZERO = 96;

using bf16 = __hip_bfloat16;
typedef short bf16x8 __attribute__((ext_vector_type(8)));
typedef short s16x4 __attribute__((ext_vector_type(4)));
typedef float f32x16 __attribute__((ext_vector_type(16)));
typedef float f32x4 __attribute__((ext_vector_type(4)));
typedef unsigned u32x4 __attribute__((ext_vector_type(4)));
template <class A, class Bt> struct same_t { static constexpr bool v = false; };
template <class A> struct same_t<A, A> { static constexpr bool v = true; };

#define KSWZ(row, colB) ((row) * 256 + ((colB) ^ (((row) & 7) << 4)))
#define SBAR() __builtin_amdgcn_sched_barrier(0)
__device__ __forceinline__ int v_st(int k, int c) { const int kk = (k & ~0xC) | ((k & 4) << 1) | ((k & 8) >> 1); return ((kk >> 3) * 4 + (c >> 5)) * 512 + ((kk & 7) * 32 + (c & 31)) * 2; }
__device__ __forceinline__ int v_rd_base(int lane) { return ((lane & 3) << 3) | (((lane >> 2) & 3) << 6) | (((lane >> 4) & 1) << 5) | (((lane >> 5) & 1) << 8); }
constexpr int v_rd_off(int d0, int ks, int half) { return d0 * 512 + ks * 4096 + half * 2048; }
__device__ __forceinline__ int crow(int r, int hi) { return (r & 3) + 8 * (r >> 2) + 4 * hi; }
__device__ __forceinline__ unsigned cvtpk(float lo, float hi) {
    unsigned r; asm volatile("v_cvt_pk_bf16_f32 %0, %1, %2" : "=v"(r) : "v"(lo), "v"(hi)); return r;
}
__device__ __forceinline__ bf16x8 pack8(f32x4 a, f32x4 b) {
    u32x4 w = {cvtpk(a[0], a[1]), cvtpk(a[2], a[3]), cvtpk(b[0], b[1]), cvtpk(b[2], b[3])};
    return *reinterpret_cast<bf16x8*>(&w);
}
template <class T> __device__ __forceinline__ bf16x8 load8(const T* p) {
    if constexpr (same_t<T, float>::v) { return pack8(*(const f32x4*)p, *(const f32x4*)(p + 4)); }
    else { return *reinterpret_cast<const bf16x8*>(p); }
}
__device__ __forceinline__ void mask_tile(f32x16& p0, f32x16& p1, int dq, unsigned W, const float* bt) {
    const float NEG = -__builtin_inff();
    const float* b = bt + (dq + BT_ZERO - 64);
#pragma unroll
    for (int r = 0; r < 16; ++r) {
        const int c = (r & 3) + 8 * (r >> 2);
        const float b0 = b[64 - c], b1 = b[32 - c];
        p0[r] = ((unsigned)(dq - c) >= W) ? NEG : p0[r] + b0;
        p1[r] = ((unsigned)(dq - c - 32) >= W) ? NEG : p1[r] + b1;
    }
}
__device__ __forceinline__ void partialSM(f32x16& p0, f32x16& p1, float& m_reg, float& mn, float& alpha) {
    float pmax = p0[0]; for (int r = 1; r < 16; ++r) pmax = fmaxf(pmax, p0[r]); for (int r = 0; r < 16; ++r) pmax = fmaxf(pmax, p1[r]);
    { auto rr = __builtin_amdgcn_permlane32_swap(__float_as_uint(pmax), __float_as_uint(pmax), false, false);
      pmax = fmaxf(__uint_as_float(rr[0]), __uint_as_float(rr[1])); }
    constexpr float C2 = 1.4426950408889634f * SCALE;
    if (__builtin_expect(__all((pmax - m_reg) * SCALE <= THR), 1)) { mn = m_reg; alpha = 1.f; }
    else { mn = fmaxf(m_reg, pmax); alpha = __builtin_amdgcn_exp2f((m_reg - mn) * C2); m_reg = mn; }
    const float mnL = -mn * C2;
    for (int r = 0; r < 16; ++r) p0[r] = fmaf(p0[r], C2, mnL); for (int r = 0; r < 16; ++r) p1[r] = fmaf(p1[r], C2, mnL);
    for (int r = 0; r < 16; ++r) p0[r] = __builtin_amdgcn_exp2f(p0[r]);
}
__device__ __forceinline__ void finishSM(f32x16& p0, f32x16& p1, float alpha, float& l_reg, bf16x8& pa0, bf16x8& pa1, bf16x8& pa2, bf16x8& pa3) {
    for (int r = 0; r < 16; ++r) p1[r] = __builtin_amdgcn_exp2f(p1[r]);
    float ps = 0; for (int r = 0; r < 16; ++r) ps += p0[r]; for (int r = 0; r < 16; ++r) ps += p1[r];
    { auto rr = __builtin_amdgcn_permlane32_swap(__float_as_uint(ps), __float_as_uint(ps), false, false);
      ps = __uint_as_float(rr[0]) + __uint_as_float(rr[1]); }
    l_reg = l_reg * alpha + ps;
#define PK4(P, B_, OUT) do { unsigned a0 = cvtpk(P[B_+0], P[B_+1]), a1 = cvtpk(P[B_+2], P[B_+3]);                          \
        unsigned b0 = cvtpk(P[B_+4], P[B_+5]), b1 = cvtpk(P[B_+6], P[B_+7]);                                             \
        auto r0 = __builtin_amdgcn_permlane32_swap(a0, b0, false, false); auto r1 = __builtin_amdgcn_permlane32_swap(a1, b1, false, false); \
        u32x4 w = {r0[0], r1[0], r0[1], r1[1]}; OUT = *reinterpret_cast<bf16x8*>(&w); } while (0)
    PK4(p0, 0, pa0); PK4(p0, 8, pa1); PK4(p1, 0, pa2); PK4(p1, 8, pa3);
#undef PK4
}
template <int KB, bool SK>
__device__ __forceinline__ void qkt(f32x16& p0, f32x16& p1, const char* K_lds, int r32, int hi, const bf16x8* qr, bool act) {
    if (SK && !act) { const float NEG = -__builtin_inff();
#pragma unroll
        for (int r = 0; r < 16; ++r) { p0[r] = NEG; p1[r] = NEG; } return; }
    p0 = f32x16{}; p1 = f32x16{};
    const char* kb[4];
#pragma unroll
    for (int dd = 0; dd < 4; ++dd) kb[dd] = K_lds + KB * SHM_K + KSWZ(r32, (dd * 16 + hi * 8) * 2);
#pragma unroll
    for (int d0 = 0; d0 < 8; ++d0) { const char* a = kb[d0 & 3] + (d0 >> 2) * 128;
        bf16x8 b0 = *reinterpret_cast<const bf16x8*>(a);
        bf16x8 b1 = *reinterpret_cast<const bf16x8*>(a + 32 * 256);
        p0 = __builtin_amdgcn_mfma_f32_32x32x16_bf16(b0, qr[d0], p0, 0, 0, 0);
        p1 = __builtin_amdgcn_mfma_f32_32x32x16_bf16(b1, qr[d0], p1, 0, 0, 0); }
}
template <int VB, bool SK>
__device__ __forceinline__ void pv_tile(f32x16* o, int vb0, bf16x8 pa0, bf16x8 pa1, bf16x8 pa2, bf16x8 pa3, bool act) {
    if (SK && !act) return;
#define TRRD(dst, off) asm volatile("ds_read_b64_tr_b16 %0, %1 offset:%2" : "=&v"(dst) : "v"(vb0), "i"(off) : "memory")
#define PV_D0(d0) do { s16x4 l0, l1, l2, l3, h0, h1, h2, h3; constexpr int b_ = VB * SHM_V + v_rd_off(d0, 0, 0);     \
        TRRD(l0, b_); TRRD(h0, b_ + 2048); TRRD(l1, b_ + 4096); TRRD(h1, b_ + 6144); TRRD(l2, b_ + 8192); TRRD(h2, b_ + 10240); TRRD(l3, b_ + 12288); TRRD(h3, b_ + 14336); \
        asm volatile("s_waitcnt lgkmcnt(0)" ::: "memory"); SBAR();                 \
        o[d0] = __builtin_amdgcn_mfma_f32_32x32x16_bf16(pa0, (bf16x8){l0[0], l0[1], l0[2], l0[3], h0[0], h0[1], h0[2], h0[3]}, o[d0], 0, 0, 0);   \
        o[d0] = __builtin_amdgcn_mfma_f32_32x32x16_bf16(pa1, (bf16x8){l1[0], l1[1], l1[2], l1[3], h1[0], h1[1], h1[2], h1[3]}, o[d0], 0, 0, 0);   \
        o[d0] = __builtin_amdgcn_mfma_f32_32x32x16_bf16(pa2, (bf16x8){l2[0], l2[1], l2[2], l2[3], h2[0], h2[1], h2[2], h2[3]}, o[d0], 0, 0, 0);   \
        o[d0] = __builtin_amdgcn_mfma_f32_32x32x16_bf16(pa3, (bf16x8){l3[0], l3[1], l3[2], l3[3], h3[0], h3[1], h3[2], h3[3]}, o[d0], 0, 0, 0); } while (0)
    PV_D0(0); PV_D0(1); PV_D0(2); PV_D0(3);
#undef PV_D0
#undef TRRD
}

template <class TIn, class TOut> struct BlockRef { const TIn* Q; const TIn* K; const TIn* V; TOut* O; float* LSE; const float* RB; int P0; int RS; int dil; int flags; };
template <class TIn> struct Seam {
    int par;
    bf16x8 qr[8];
    bf16x8 st_v0, st_v1, st_k0, st_k1; f32x4 sf0, sf1, sf2, sf3;
    f32x4 tq[16];
};
__device__ __forceinline__ int swa_jlo(int P0, int W) { const int lowk = P0 - W + 1; return lowk > 0 ? lowk / KVBLK : 0; }
#define ROW(p, k0, rr) ((p) + (size_t)((k0) + (rr)) * RSX + sc)
#define VMW() asm volatile("s_waitcnt vmcnt(0)" ::: "memory")
#define VMWN(n) asm volatile("s_waitcnt vmcnt(%0)" :: "i"(n) : "memory")
#define SLOAD_H(Kp, Vp, k0) do { S.st_v0 = load8<TIn>(ROW(Vp, k0, sr)); S.st_v1 = load8<TIn>(ROW(Vp, k0, 32 + sr));              \
                         S.st_k0 = load8<TIn>(ROW(Kp, k0, sr)); S.st_k1 = load8<TIn>(ROW(Kp, k0, 32 + sr)); } while (0)
#define SWRITE_HK(bf) do { *(bf16x8*)(K_lds + (bf) * SHM_K + kws) = S.st_k0; *(bf16x8*)(K_lds + (bf) * SHM_K + kws + 32 * 256) = S.st_k1; } while (0)
#define SWRITE_HV(bf) do { *(bf16x8*)(V_lds + (bf) * SHM_V + vst0) = S.st_v0; *(bf16x8*)(V_lds + (bf) * SHM_V + vst1) = S.st_v1; } while (0)
#define SWRITE_H(bf) do { SWRITE_HV(bf); SWRITE_HK(bf); } while (0)
#define SLOAD_F(p, k0) do { S.sf0 = *(const f32x4*)ROW(p, k0, sr); S.sf1 = *(const f32x4*)(ROW(p, k0, sr) + 4);                \
                            S.sf2 = *(const f32x4*)ROW(p, k0, 32 + sr); S.sf3 = *(const f32x4*)(ROW(p, k0, 32 + sr) + 4); } while (0)
#define SWRITE_KF(bf) do { *(bf16x8*)(K_lds + (bf) * SHM_K + kws) = pack8(S.sf0, S.sf1); *(bf16x8*)(K_lds + (bf) * SHM_K + kws + 32 * 256) = pack8(S.sf2, S.sf3); } while (0)
#define SWRITE_VF(bf) do { *(bf16x8*)(V_lds + (bf) * SHM_V + vst0) = pack8(S.sf0, S.sf1); *(bf16x8*)(V_lds + (bf) * SHM_V + vst1) = pack8(S.sf2, S.sf3); } while (0)
__device__ __forceinline__ void fill_bias(float* tbl, const float* RB, int dil) {
    const int tid = tidx();
    if (tid < BT_N) { const int delta = tid - BT_ZERO; float v = 0.f;
        if (delta >= 0 && delta <= 128) { const int dist = delta * dil; int bk;
            if (dist < 16) bk = dist; else { const float d = (float)dist; const int lg = 16 + (int)(logf(d / 16.0f) / 4.852030263919617f * 16.0f); bk = lg < 31 ? lg : 31; }
            v = RB[bk * 16]; }
        tbl[tid] = v; }
}
template <class TIn, class TOut>
__device__ __forceinline__ void causal_swa_prime(const BlockRef<TIn, TOut>& cur, int W, char* lds, Seam<TIn>& S) {
    constexpr bool F32 = same_t<TIn, float>::v;
    const int tid = tidx(), wid = __builtin_amdgcn_readfirstlane(tid >> 6), lane = tid & 63, r32 = lane & 31, hi = lane >> 5;
    const int sr = tid >> 4, sc = (tid & 15) * 8, kws = KSWZ(sr, sc * 2); char* K_lds = lds + 2 * SHM_V;
    const int kb0 = swa_jlo(cur.P0, W) * KVBLK; const int RSX = cur.RS;
    S.par = 0; fill_bias((float*)(lds + BT_OFF), cur.RB, cur.dil);
    for (int d0 = 0; d0 < 8; ++d0) S.qr[d0] = load8<TIn>(cur.Q + (size_t)(wid * QBLK + r32) * cur.RS + d0 * 16 + hi * 8);
    if constexpr (F32) { SLOAD_F((const float*)cur.K, kb0); VMW(); SWRITE_KF(0); SBAR(); SLOAD_F((const float*)cur.V, kb0); }
    else { SLOAD_H(cur.K, cur.V, kb0); VMW(); SWRITE_HK(0); }
    __syncthreads();
}
template <class TIn, class TOut>
__device__ __forceinline__ void causal_swa_block(const BlockRef<TIn, TOut>& cur, const BlockRef<TIn, TOut>& nxt, int skv, int W, char* lds, Seam<TIn>& S) {
    constexpr bool F32 = same_t<TIn, float>::v;
    const int tid = tidx(), wid = __builtin_amdgcn_readfirstlane(tid >> 6), lane = tid & 63, r32 = lane & 31, hi = lane >> 5;
    const int j_lo = swa_jlo(cur.P0, W); int RSX = cur.RS;
    const float* bt = (const float*)(lds + BT_OFF) + S.par * BT_N;
    int j_hi = (cur.P0 + QB - 1) / KVBLK + 1; if (j_hi > skv / KVBLK) j_hi = skv / KVBLK;
    const int NT = j_hi - j_lo;
    const int kbn = swa_jlo(nxt.P0, W) * KVBLK;
    const int qlo = cur.P0 + wid * QBLK, qm = qlo + r32 - 4 * hi;
    char* V_lds = lds; char* K_lds = lds + 2 * SHM_V;
    float* ws = (float*)(lds + 2 * SHM_V + 2 * SHM_K) + wid * 64; float* li_l = ws, * al_l = ws + 32;
    float m_reg = -1e30f, l_reg = 0; f32x16 o[4] = {};
    const int sr = tid >> 4, sc = (tid & 15) * 8, vst0 = v_st(sr, sc), vst1 = v_st(32 + sr, sc), kws = KSWZ(sr, sc * 2);
    const int vb0 = (int)(uintptr_t)V_lds + v_rd_base(lane);
    const TIn* Kh = cur.K; const TIn* Vh = cur.V;
#define RESC(a) do { if (__any((a) < 1.f)) { if (hi == 0) al_l[r32] = (a); asm volatile("s_waitcnt lgkmcnt(0)" ::: "memory");              \
                     for (int d_ = 0; d_ < 4; ++d_) for (int r = 0; r < 16; ++r) o[d_][r] *= al_l[crow(r, hi)]; } } while (0)
#define KBASE(t) ((j_lo + (t)) * KVBLK)
#define ACT(t) (KBASE(t) <= qlo + QBLK - 1 && KBASE(t) + KVBLK - 1 >= qlo - W + 1)
#define MASKT(P0_, P1_, t) do { const int kb_ = KBASE(t); if (!SK || ACT(t)) mask_tile(P0_, P1_, qm - kb_, (unsigned)W, bt); } while (0)
    constexpr int NQL = F32 ? 16 : 8;
    constexpr bool SK = WSKIP && !F32;
#define SEAM_K0() do { VMWN(NQL); if constexpr (F32) { SWRITE_KF(0); SBAR(); SLOAD_F((const float*)nxt.V, kbn); } else { SWRITE_HK(0); } SBAR(); } while (0)
    f32x16 pA0, pA1, pB0, pB1; float mnA, mnB, alA, alB; bf16x8 pa0, pa1, pa2, pa3;
    if constexpr (F32) { VMW(); SWRITE_VF(0); SBAR(); } else { SWRITE_HV(0); SBAR(); }
    if (NT > 1) { if constexpr (F32) SLOAD_F((const float*)Kh, KBASE(1)); else SLOAD_H(Kh, Vh, KBASE(1)); }
    SBAR(); qkt<0, SK>(pA0, pA1, K_lds, r32, hi, S.qr, ACT(0));
    if constexpr (F32) { if (NT > 1) { VMW(); SWRITE_KF(1); SBAR(); SLOAD_F((const float*)Vh, KBASE(1)); } }
    MASKT(pA0, pA1, 0); partialSM(pA0, pA1, m_reg, mnA, alA);
    if (NT > 1) { VMW(); if constexpr (F32) { SWRITE_VF(1); SBAR(); if (NT > 2) SLOAD_F((const float*)Kh, KBASE(2)); } else SWRITE_H(1); }
    __syncthreads();
#define HALF_STEP(PX0, PX1, mnX, alX, PY0, PY1, alY, t, KB, VB, SB) do {                                                      \
        SBAR(); qkt<KB, SK>(PX0, PX1, K_lds, r32, hi, S.qr, ACT(t));                                             \
        finishSM(PY0, PY1, alY, l_reg, pa0, pa1, pa2, pa3); SBAR();                                                           \
        if ((t) + 1 < NT) { if constexpr (F32) { VMW(); SWRITE_KF(SB); SBAR(); SLOAD_F((const float*)Vh, KBASE((t) + 1)); }  \
                            else { SLOAD_H(Kh, Vh, KBASE((t) + 1)); } SBAR(); }                                               \
        pv_tile<VB, SK>(o, vb0, pa0, pa1, pa2, pa3, ACT((t) - 1)); MASKT(PX0, PX1, (t)); partialSM(PX0, PX1, m_reg, mnX, alX);                                        \
        __syncthreads();                                                                                                      \
        if ((t) + 1 < NT) { VMW(); if constexpr (F32) { SWRITE_VF(SB); SBAR(); if ((t) + 2 < NT) SLOAD_F((const float*)Kh, KBASE((t) + 2)); } \
                            else { SWRITE_H(SB); } }                                                                          \
        RESC(alX); __syncthreads(); } while (0)
    for (int t = 1; t + 1 < NT; t += 2) {
        HALF_STEP(pB0, pB1, mnB, alB, pA0, pA1, alA, t, 1, 0, 0);
        HALF_STEP(pA0, pA1, mnA, alA, pB0, pB1, alB, t + 1, 0, 1, 1);
    }
    const bool even = (NT & 1) == 0;
    if (even) { SBAR(); qkt<1, SK>(pB0, pB1, K_lds, r32, hi, S.qr, ACT(NT - 1)); SBAR(); }
#define QROW(e) (nxt.Q + (size_t)(wid * QBLK + r32) * nxt.RS + ((e) >> 1) * 16 + hi * 8 + ((e) & 1) * 4)
    RSX = nxt.RS;
    if constexpr (F32) { SLOAD_F((const float*)nxt.K, kbn); SBAR();
#pragma unroll
        for (int e = 0; e < 8; ++e) S.tq[e] = *(const f32x4*)QROW(e); }
    else { SLOAD_H(nxt.K, nxt.V, kbn); SBAR();
#pragma unroll
        for (int d0 = 0; d0 < 8; ++d0) S.qr[d0] = load8<TIn>(nxt.Q + (size_t)(wid * QBLK + r32) * nxt.RS + d0 * 16 + hi * 8); }
    SBAR();
    finishSM(pA0, pA1, alA, l_reg, pa0, pa1, pa2, pa3); SBAR();
    if constexpr (F32) {
#pragma unroll
        for (int e = 8; e < 16; ++e) S.tq[e] = *(const f32x4*)QROW(e); SBAR(); }
#undef QROW
    pv_tile<0, SK>(o, vb0, pa0, pa1, pa2, pa3, ACT(even ? NT - 2 : NT - 1));
    if (even) { MASKT(pB0, pB1, NT - 1); partialSM(pB0, pB1, m_reg, mnB, alB); __syncthreads(); RESC(alB);
        finishSM(pB0, pB1, alB, l_reg, pa0, pa1, pa2, pa3); SBAR(); pv_tile<1, SK>(o, vb0, pa0, pa1, pa2, pa3, ACT(NT - 1)); }
    SBAR(); SEAM_K0();
    if (hi == 0) { li_l[r32] = l_reg; cur.LSE[(size_t)(wid * QBLK + r32) * (size_t)(16 * cur.dil)] = m_reg * SCALE + __logf(l_reg); }
    fill_bias((float*)(lds + BT_OFF) + (S.par ^ 1) * BT_N, nxt.RB, nxt.dil); S.par ^= 1;
    asm volatile("s_waitcnt lgkmcnt(0)" ::: "memory");
    float rli[16];
#pragma unroll
    for (int r = 0; r < 16; ++r) rli[r] = __builtin_amdgcn_rcpf(li_l[crow(r, hi)]);
    TOut* Ow = cur.O + (size_t)(wid * QBLK) * cur.RS + (size_t)(4 * hi) * cur.RS;
#pragma unroll
    for (int r = 0; r < 16; ++r) { const int orow = (r & 3) + 8 * (r >> 2);
#pragma unroll
        for (int d0 = 0; d0 < 4; ++d0) { const float v = o[d0][r] * rli[r];
            if constexpr (same_t<TOut, float>::v) { Ow[(size_t)orow * cur.RS + d0 * 32 + r32] = v; }
            else { const float vn = __shfl_xor(v, 1);
                   if ((r32 & 1) == 0) *(unsigned*)(Ow + (size_t)orow * cur.RS + d0 * 32 + r32) = cvtpk(v, vn); } } }
    if constexpr (F32) {
#pragma unroll
        for (int d0 = 0; d0 < 8; ++d0) S.qr[d0] = pack8(S.tq[2 * d0], S.tq[2 * d0 + 1]); }
    __syncthreads();
#undef RESC
#undef KBASE
#undef ACT
#undef MASKT
#undef SEAM_K0
#undef HALF_STEP
}
#undef ROW
#undef VMW
#undef VMWN
#undef SLOAD_H
#undef SWRITE_HK
#undef SWRITE_HV
#undef SWRITE_H
#undef SLOAD_F
#undef SWRITE_KF
#undef SWRITE_VF
constexpr int A2_V = 0, A2_K = 4 * SHM_V, A2_WS = A2_K + 4 * SHM_K, A2_BT = A2_WS + NW * 64 * 4, A2_OST = A2_BT + 2 * BT_N * 4  , A2_BYTES = A2_OST + NW * 2560;
struct Seam2 { int par; int g; bf16x8 qr[8]; };
typedef __attribute__((address_space(3))) char a2_lchar;
#define A2_VMW() asm volatile("s_waitcnt vmcnt(0)" ::: "memory")
#define A2_VMWN(n) asm volatile("s_waitcnt vmcnt(%0)" :: "i"(n) : "memory")
#define A2_BAR() do { asm volatile("s_waitcnt lgkmcnt(0)" ::: "memory"); __builtin_amdgcn_s_barrier(); asm volatile("" ::: "memory"); } while (0)
#define A2_GLDS(Kp, Vp, rs, k0, b) do { const size_t rs_ = (size_t)(rs);                                                                              \
        const __hip_bfloat16* kp_ = (Kp) + (size_t)(k0) * rs_ + (size_t)sr * rs_ + ckK; const __hip_bfloat16* vp_ = (Vp) + (size_t)(k0) * rs_ + (size_t)kV * rs_ + ckV;           \
        a2_lchar* kd_ = ldsl + A2_K + (b) * SHM_K + wid * 1024; a2_lchar* vd_ = ldsl + A2_V + (b) * SHM_V + wid * 1024;                                  \
        __builtin_amdgcn_global_load_lds((const unsigned*)kp_, (__attribute__((address_space(3))) unsigned*)kd_, 16, 0, 0);                              \
        __builtin_amdgcn_global_load_lds((const unsigned*)(kp_ + 32 * rs_), (__attribute__((address_space(3))) unsigned*)(kd_ + 8192), 16, 0, 0);          \
        __builtin_amdgcn_global_load_lds((const unsigned*)vp_, (__attribute__((address_space(3))) unsigned*)vd_, 16, 0, 0);                              \
        __builtin_amdgcn_global_load_lds((const unsigned*)(vp_ + 32 * rs_), (__attribute__((address_space(3))) unsigned*)(vd_ + 8192), 16, 0, 0); } while (0)
#define A2_LANE_CONSTS() const int tid = tidx(), wid = __builtin_amdgcn_readfirstlane(tid >> 6), lane = tid & 63, r32 = lane & 31, hi = lane >> 5;            \
    const int sr = tid >> 4, ckK = ((tid & 15) ^ (sr & 7)) * 8;                                                                                           \
    const int kkV = ((tid >> 7) << 3) | ((tid & 31) >> 2), kV = (kkV & ~0xC) | ((kkV & 4) << 1) | ((kkV & 8) >> 1), ckV = (((tid >> 5) & 3) << 5) | ((tid & 3) << 3)

template <bool SK>
__device__ __forceinline__ void qkt2(f32x16& p0, f32x16& p1, const char* Kt, int r32, int hi, const bf16x8* qr, bool act) {
    if (SK && !act) { const float NEG = -__builtin_inff();
#pragma unroll
        for (int r = 0; r < 16; ++r) { p0[r] = NEG; p1[r] = NEG; } return; }
    p0 = f32x16{}; p1 = f32x16{};
    const char* kb[4];
#pragma unroll
    for (int dd = 0; dd < 4; ++dd) kb[dd] = Kt + KSWZ(r32, (dd * 16 + hi * 8) * 2);
#pragma unroll
    for (int d0 = 0; d0 < 8; ++d0) { const char* a = kb[d0 & 3] + (d0 >> 2) * 128;
        bf16x8 b0 = *reinterpret_cast<const bf16x8*>(a);
        bf16x8 b1 = *reinterpret_cast<const bf16x8*>(a + 32 * 256);
        p0 = __builtin_amdgcn_mfma_f32_32x32x16_bf16(b0, qr[d0], p0, 0, 0, 0);
        p1 = __builtin_amdgcn_mfma_f32_32x32x16_bf16(b1, qr[d0], p1, 0, 0, 0); }
}
template <bool SK>
__device__ __forceinline__ void pv2(f32x16* o, int vbx, bf16x8 pa0, bf16x8 pa1, bf16x8 pa2, bf16x8 pa3, bool act) {
    if (SK && !act) return;
#define TRRD(dst, off) asm volatile("ds_read_b64_tr_b16 %0, %1 offset:%2" : "=&v"(dst) : "v"(vbx), "i"(off) : "memory")
#define PV_D0(d0) do { s16x4 l0, l1, l2, l3, h0, h1, h2, h3; constexpr int b_ = v_rd_off(d0, 0, 0);                                                     \
        TRRD(l0, b_); TRRD(h0, b_ + 2048); TRRD(l1, b_ + 4096); TRRD(h1, b_ + 6144); TRRD(l2, b_ + 8192); TRRD(h2, b_ + 10240); TRRD(l3, b_ + 12288); TRRD(h3, b_ + 14336); \
        asm volatile("s_waitcnt lgkmcnt(0)" ::: "memory"); SBAR();                                                                                     \
        o[d0] = __builtin_amdgcn_mfma_f32_32x32x16_bf16(pa0, (bf16x8){l0[0], l0[1], l0[2], l0[3], h0[0], h0[1], h0[2], h0[3]}, o[d0], 0, 0, 0);   \
        o[d0] = __builtin_amdgcn_mfma_f32_32x32x16_bf16(pa1, (bf16x8){l1[0], l1[1], l1[2], l1[3], h1[0], h1[1], h1[2], h1[3]}, o[d0], 0, 0, 0);   \
        o[d0] = __builtin_amdgcn_mfma_f32_32x32x16_bf16(pa2, (bf16x8){l2[0], l2[1], l2[2], l2[3], h2[0], h2[1], h2[2], h2[3]}, o[d0], 0, 0, 0);   \
        o[d0] = __builtin_amdgcn_mfma_f32_32x32x16_bf16(pa3, (bf16x8){l3[0], l3[1], l3[2], l3[3], h3[0], h3[1], h3[2], h3[3]}, o[d0], 0, 0, 0); } while (0)
    PV_D0(0); PV_D0(1); PV_D0(2); PV_D0(3);
#undef PV_D0
#undef TRRD
}
template <class TIn, class TOut>
__device__ __forceinline__ void a2_prime(const BlockRef<TIn, TOut>& cur, int W, char* lds, a2_lchar* ldsl, Seam2& S) {
    A2_LANE_CONSTS();
    S.par = 0; S.g = 0; fill_bias((float*)(lds + A2_BT), cur.RB, cur.dil);
    const int kb0 = swa_jlo(cur.P0, W) * KVBLK;
    A2_GLDS(cur.K, cur.V, cur.RS, kb0, 0); A2_GLDS(cur.K, cur.V, cur.RS, kb0 + KVBLK, 1);
#pragma unroll
    for (int d0 = 0; d0 < 8; ++d0) S.qr[d0] = load8<TIn>(cur.Q + (size_t)(wid * QBLK + r32) * cur.RS + d0 * 16 + hi * 8);
    A2_VMW();
#pragma unroll
    for (int d0 = 0; d0 < 8; ++d0) asm volatile("" : "+v"(S.qr[d0]));
}
template <class TIn, class TOut>
__device__ __forceinline__ void a2_block(const BlockRef<TIn, TOut>& cur, const BlockRef<TIn, TOut>& nxt, int W, char* lds, a2_lchar* ldsl, Seam2& S) {
    A2_LANE_CONSTS();
    constexpr bool SK = true;
    const int j_lo = swa_jlo(cur.P0, W), NT = (cur.P0 + QB - 1) / KVBLK + 1 - j_lo;
    const int kbn = swa_jlo(nxt.P0, W) * KVBLK, g = S.g;
    const int qlo = cur.P0 + wid * QBLK, qm = qlo + r32 - 4 * hi;
    const char* K_lds = lds + A2_K; const int vb0 = (int)(uintptr_t)(lds + A2_V) + v_rd_base(lane);
    float* ws = (float*)(lds + A2_WS) + wid * 64; float* li_l = ws, * al_l = ws + 32;
    const float* bt = (const float*)(lds + A2_BT) + S.par * BT_N;
    float m_reg = -1e30f, l_reg = 0; f32x16 o[4] = {};
#define RESC(a) do { if (__any((a) < 1.f)) { if (hi == 0) al_l[r32] = (a); asm volatile("s_waitcnt lgkmcnt(0)" ::: "memory");              \
                     for (int d_ = 0; d_ < 4; ++d_) for (int r = 0; r < 16; ++r) o[d_][r] *= al_l[crow(r, hi)]; } } while (0)
#define KBASE(t) ((j_lo + (t)) * KVBLK)
#define SLOT(t) (((g + (t)) & 3) * SHM_K)
#define ACT(t) (KBASE(t) <= qlo + QBLK - 1 && KBASE(t) + KVBLK - 1 >= qlo - W + 1)
#define MASKT(P0_, P1_, t) do { if (ACT(t)) mask_tile(P0_, P1_, qm - KBASE(t), (unsigned)W, bt); } while (0)
    f32x16 pA0, pA1, pB0, pB1; float mnA, mnB, alA, alB; bf16x8 pa0, pa1, pa2, pa3;
    A2_BAR();
    A2_GLDS(cur.K, cur.V, cur.RS, KBASE(2), (g + 2) & 3);
    SBAR(); qkt2<SK>(pA0, pA1, K_lds + SLOT(0), r32, hi, S.qr, ACT(0));
    MASKT(pA0, pA1, 0); partialSM(pA0, pA1, m_reg, mnA, alA);
#define STEP(PX0, PX1, mnX, alX, PY0, PY1, alY, t) do {                                                                                       \
        if ((t) + 2 < NT) A2_GLDS(cur.K, cur.V, cur.RS, KBASE((t) + 2), (g + (t) + 2) & 3);                                                   \
        SBAR(); qkt2<SK>(PX0, PX1, K_lds + SLOT(t), r32, hi, S.qr, ACT(t));                                                                   \
        finishSM(PY0, PY1, alY, l_reg, pa0, pa1, pa2, pa3); SBAR();                                                                           \
        pv2<SK>(o, vb0 + SLOT((t) - 1), pa0, pa1, pa2, pa3, ACT((t) - 1)); MASKT(PX0, PX1, (t)); partialSM(PX0, PX1, m_reg, mnX, alX);       \
        RESC(alX);                                                                                                                            \
        if ((t) + 2 < NT) A2_VMWN(4); else A2_VMW();                                \
        A2_BAR(); } while (0)
    for (int t = 1; t + 1 < NT - 1; t += 2) {
        STEP(pB0, pB1, mnB, alB, pA0, pA1, alA, t);
        STEP(pA0, pA1, mnA, alA, pB0, pB1, alB, t + 1);
    }
    const bool newtab = (nxt.RB != cur.RB) || (nxt.dil != cur.dil);
    if (newtab) fill_bias((float*)(lds + A2_BT) + (S.par ^ 1) * BT_N, nxt.RB, nxt.dil);
    A2_GLDS(nxt.K, nxt.V, nxt.RS, kbn, (g + NT) & 3); A2_GLDS(nxt.K, nxt.V, nxt.RS, kbn + KVBLK, (g + NT + 1) & 3);
    SBAR(); qkt2<SK>(pB0, pB1, K_lds + SLOT(NT - 1), r32, hi, S.qr, ACT(NT - 1)); SBAR();
#pragma unroll
    for (int d0 = 0; d0 < 8; ++d0) S.qr[d0] = load8<TIn>(nxt.Q + (size_t)(wid * QBLK + r32) * nxt.RS + d0 * 16 + hi * 8);
    SBAR();
    finishSM(pA0, pA1, alA, l_reg, pa0, pa1, pa2, pa3); SBAR();
    pv2<SK>(o, vb0 + SLOT(NT - 2), pa0, pa1, pa2, pa3, ACT(NT - 2));
    MASKT(pB0, pB1, NT - 1); partialSM(pB0, pB1, m_reg, mnB, alB); RESC(alB);
    finishSM(pB0, pB1, alB, l_reg, pa0, pa1, pa2, pa3); SBAR();
    pv2<SK>(o, vb0 + SLOT(NT - 1), pa0, pa1, pa2, pa3, ACT(NT - 1));
    A2_VMW();
#pragma unroll
    for (int d0 = 0; d0 < 8; ++d0) asm volatile("" : "+v"(S.qr[d0]));
    if (hi == 0) { li_l[r32] = l_reg; cur.LSE[(size_t)(wid * QBLK + r32) * (size_t)(16 * cur.dil)] = m_reg * SCALE + __logf(l_reg); }
    asm volatile("s_waitcnt lgkmcnt(0)" ::: "memory");
    float rli[16];
#pragma unroll
    for (int r = 0; r < 16; ++r) rli[r] = __builtin_amdgcn_rcpf(li_l[crow(r, hi)]);
    if (!(cur.flags & 1)) {
        char* st = lds + A2_OST + wid * 2560; char* stw = st + (4 * hi) * 80 + r32 * 2;
        TOut* Og = cur.O + (size_t)(wid * QBLK) * cur.RS;
#pragma unroll
        for (int d0 = 0; d0 < 4; ++d0) {
#pragma unroll
            for (int r = 0; r < 16; ++r) { const float v = o[d0][r] * rli[r]; const float vn = __shfl_xor(v, 1);
                if ((r32 & 1) == 0) *(unsigned*)(stw + ((r & 3) + 8 * (r >> 2)) * 80) = cvtpk(v, vn); }
            asm volatile("s_waitcnt lgkmcnt(0)" ::: "memory");
            u32x4 w0 = *(const u32x4*)(st + (lane >> 2) * 80 + (lane & 3) * 16), w1 = *(const u32x4*)(st + (16 + (lane >> 2)) * 80 + (lane & 3) * 16);
            asm volatile("s_waitcnt lgkmcnt(0)" ::: "memory");
            *(u32x4*)(Og + (size_t)(lane >> 2) * cur.RS + d0 * 32 + (lane & 3) * 8) = w0;
            *(u32x4*)(Og + (size_t)(16 + (lane >> 2)) * cur.RS + d0 * 32 + (lane & 3) * 8) = w1; }
    }
    if (newtab) S.par ^= 1;
    S.g = (g + NT) & 3;
#undef RESC
#undef KBASE
#undef SLOT
#undef ACT
#undef MASKT
#undef STEP
}
}
typedef unsigned short bf16_t;
typedef short bf16x8 __attribute__((ext_vector_type(8)));
typedef float f32x4 __attribute__((ext_vector_type(4)));
typedef float f32x2 __attribute__((ext_vector_type(2)));
typedef unsigned u32x4 __attribute__((ext_vector_type(4)));
typedef unsigned u32x2 __attribute__((ext_vector_type(2)));
__device__ __forceinline__ unsigned cvtpk2(float lo, float hi) { unsigned r; asm volatile("v_cvt_pk_bf16_f32 %0, %1, %2" : "=v"(r) : "v"(lo), "v"(hi)); return r; }
__device__ __forceinline__ float bf_lo(unsigned w) { return __uint_as_float(w << 16); }
__device__ __forceinline__ float bf_hi(unsigned w) { return __uint_as_float(w & 0xffff0000u); }
__device__ __forceinline__ float wave_sum(float v) {
#pragma unroll
    for (int o = 32; o >= 1; o >>= 1) v += __shfl_xor(v, o);
    return v;
}

__device__ __forceinline__ void p0_rmsnorm_x(const float* __restrict__ x, const float* __restrict__ g, bf16_t* __restrict__ hn, int G) {
    const int lane = tidx() & 63, wid = tidx() >> 6;
    for (int row = blockIdx.x * 8 + wid; row < M_TOK; row += G * 8) {
        const float* xr = x + (size_t)row * DM; f32x4 v[16]; float s = 0.f;
#pragma unroll
        for (int j = 0; j < 8; ++j) { v[2 * j] = *(const f32x4*)(xr + (j * 64 + lane) * 8); v[2 * j + 1] = *(const f32x4*)(xr + (j * 64 + lane) * 8 + 4); }
#pragma unroll
        for (int j = 0; j < 16; ++j) s += (v[j][0] * v[j][0] + v[j][1] * v[j][1]) + (v[j][2] * v[j][2] + v[j][3] * v[j][3]);
        s = wave_sum(s);
        const float rs = __builtin_amdgcn_rsqf(s * (1.0f / DM) + EPS);
#pragma unroll
        for (int j = 0; j < 8; ++j) { const int c = (j * 64 + lane) * 8; const f32x4 g0 = *(const f32x4*)(g + c), g1 = *(const f32x4*)(g + c + 4);
            const f32x4 a = v[2 * j] * rs * g0, b = v[2 * j + 1] * rs * g1;
            u32x4 w; w.x = cvtpk2(a[0], a[1]); w.y = cvtpk2(a[2], a[3]); w.z = cvtpk2(b[0], b[1]); w.w = cvtpk2(b[2], b[3]);
            *(u32x4*)(hn + (size_t)row * DM + c) = w; }
    }
}
__device__ __forceinline__ void p0_transpose_item(const float* __restrict__ W, const float* __restrict__ sc, int K, int N, bf16_t* __restrict__ WT, LAS float* scr, int item, int lane) {
    const int nblk = N / 32, kb = item / nblk, nb = item % nblk, k0 = 64 * kb, n0 = 32 * nb;
    f32x4 r[8];
#pragma unroll
    for (int i = 0; i < 8; ++i) r[i] = *(const f32x4*)(W + (size_t)(k0 + 8 * i + (lane >> 3)) * N + n0 + 4 * (lane & 7));
    if (sc) {
#pragma unroll
        for (int i = 0; i < 8; ++i) r[i] = r[i] * sc[k0 + 8 * i + (lane >> 3)]; }
#pragma unroll
    for (int i = 0; i < 8; ++i) { LAS float* d = scr + (8 * i + (lane >> 3)) * 33 + 4 * (lane & 7); d[0] = r[i][0]; d[1] = r[i][1]; d[2] = r[i][2]; d[3] = r[i][3]; }
    asm volatile("s_waitcnt lgkmcnt(0)" ::: "memory");
    const int c = lane & 7;
#pragma unroll
    for (int j = 0; j < 4; ++j) { const int n = (lane >> 3) + 8 * j; const LAS float* t = scr + (8 * c) * 33 + n;
        u32x4 o; o.x = cvtpk2(t[0 * 33], t[1 * 33]); o.y = cvtpk2(t[2 * 33], t[3 * 33]); o.z = cvtpk2(t[4 * 33], t[5 * 33]); o.w = cvtpk2(t[6 * 33], t[7 * 33]);
        *(u32x4*)(WT + (size_t)(n0 + n) * K + k0 + 8 * c) = o; }
    asm volatile("s_waitcnt lgkmcnt(0)" ::: "memory");
}
__device__ __forceinline__ void p0_weights(const float* w_in, const float* w_out, const float* w_gate, const float* g_ple, const float* w_up,
                                           bf16_t* WIN, bf16_t* WOUT, bf16_t* WG, bf16_t* WUP, int G, LAS unsigned char* lds) {
    const int tid = tidx(), lane = tid & 63, wave = tid >> 6;
    LAS float* scr = (LAS float*)(lds + wave * 16384);
    constexpr int I_IN = (DM / 64) * (DIN / 32), I_SQ = (DM / 64) * (DM / 32), I_UP = (DPLE / 64) * (DM / 32), NITEMS = I_IN + 2 * I_SQ + I_UP;
    for (int it = (int)blockIdx.x * 8 + wave; it < NITEMS; it += G * 8) {
        int r = it;
        if (r < I_IN) { p0_transpose_item(w_in, nullptr, DM, DIN, WIN, scr, r, lane); continue; } r -= I_IN;
        if (r < I_SQ) { p0_transpose_item(w_out, nullptr, DM, DM, WOUT, scr, r, lane); continue; } r -= I_SQ;
        if (r < I_SQ) { p0_transpose_item(w_gate, g_ple, DM, DM, WG, scr, r, lane); continue; } r -= I_SQ;
        p0_transpose_item(w_up, nullptr, DPLE, DM, WUP, scr, r, lane);
    }
    __syncthreads();
}
__device__ __forceinline__ void p0_convert_p(const float* __restrict__ p, bf16_t* __restrict__ pb, int G) {
    const size_t n8 = (size_t)M_TOK * DPLE / 8;
    for (size_t i = (size_t)blockIdx.x * 512 + tidx(); i < n8; i += (size_t)G * 512) { const f32x4 a = *(const f32x4*)(p + i * 8), b = *(const f32x4*)(p + i * 8 + 4);
        u32x4 w; w.x = cvtpk2(a[0], a[1]); w.y = cvtpk2(a[2], a[3]); w.z = cvtpk2(b[0], b[1]); w.w = cvtpk2(b[2], b[3]); *(u32x4*)(pb + i * 8) = w; }
}

constexpr int VT_STRIDE = 136;
__device__ __forceinline__ void p2_gmlp(bf16_t* __restrict__ AU, const bf16_t* __restrict__ AV, const float* __restrict__ lnp, const float* __restrict__ lng, const float* __restrict__ lnb,
                                         const float* __restrict__ ws, const float* __restrict__ bs, int G, LAS unsigned char* lds) {
    const int tid = tidx(), lane = tid & 63, wid = tid >> 6, fr = lane & 15, fq = lane >> 4;
    LAS float* ST = (LAS float*)(lds + 2 * 128 * VT_STRIDE * 2);
    for (int item = blockIdx.x; item < 256; item += G) {
        const int cn = item >> 1, g0 = (item & 1) * 8, T0 = cn * 128;
        u32x4 av[4];
#pragma unroll
        for (int it = 0; it < 4; ++it) { const int idx = it * 512 + tid, s = idx >> 4, ch = (idx & 15) * 8; av[it] = *(const u32x4*)(AV + (size_t)(T0 + s) * WBR + g0 * 128 + ch); }
        __syncthreads();
        if (tid < 128) { const float* pp = lnp + (size_t)(T0 + tid) * 64; float s1 = 0.f, s2 = 0.f;
#pragma unroll
            for (int i = 0; i < 16; ++i) { const f32x4 q = *(const f32x4*)(pp + 4 * i); s1 += q[0] + q[2]; s2 += q[1] + q[3]; }
            const float mean = s1 * (1.0f / WBR), var = s2 * (1.0f / WBR) - mean * mean;
            ST[2 * tid] = mean; ST[2 * tid + 1] = __builtin_amdgcn_rsqf(fmaxf(var, 0.f) + EPS); }
        __syncthreads();
        const int t = 16 * wid + fr, nks = (16 * wid + 15) / 32 + 1;
        for (int gi = 0; gi < 8; ++gi) { const int g = g0 + gi;
            LAS bf16_t* VT = (LAS bf16_t*)(lds + (gi & 1) * (128 * VT_STRIDE * 2));
            const float* wrow = ws + ((size_t)g * 128 + t) * 128; f32x4 w0[4], w1[4];
#pragma unroll
            for (int ks = 0; ks < 4; ++ks) if (ks < nks) { w0[ks] = *(const f32x4*)(wrow + 32 * ks + 8 * fq); w1[ks] = *(const f32x4*)(wrow + 32 * ks + 8 * fq + 4); }
            u32x2 au[8];
#pragma unroll
            for (int n = 0; n < 8; ++n) au[n] = *(const u32x2*)(AU + (size_t)(T0 + t) * WBR + g * 128 + 16 * n + 4 * fq);
            const float bias = bs[g * 128 + t];
#pragma unroll
            for (int it = 0; it < 4; ++it) { const int idx = it * 512 + tid, s = idx >> 4, ch = (idx & 15) * 8; const u32x4 w = av[it];
                const float mean = ST[2 * s], rstd = ST[2 * s + 1];
                const f32x4 g0v = *(const f32x4*)(lng + g * 128 + ch), g1v = *(const f32x4*)(lng + g * 128 + ch + 4), b0v = *(const f32x4*)(lnb + g * 128 + ch), b1v = *(const f32x4*)(lnb + g * 128 + ch + 4);
                float v[8] = {bf_lo(w.x), bf_hi(w.x), bf_lo(w.y), bf_hi(w.y), bf_lo(w.z), bf_hi(w.z), bf_lo(w.w), bf_hi(w.w)};
#pragma unroll
                for (int e = 0; e < 8; ++e) { const float gg = e < 4 ? g0v[e & 3] : g1v[e & 3], bb = e < 4 ? b0v[e & 3] : b1v[e & 3];
                    const float y = (v[e] - mean) * rstd * gg + bb; const unsigned pk = cvtpk2(y, y); VT[(ch + e) * VT_STRIDE + s] = (bf16_t)(pk & 0xffffu); } }
            if (gi < 7) {
#pragma unroll
                for (int it = 0; it < 4; ++it) { const int idx = it * 512 + tid, s = idx >> 4, ch = (idx & 15) * 8; av[it] = *(const u32x4*)(AV + (size_t)(T0 + s) * WBR + (g + 1) * 128 + ch); } }
            __syncthreads();
            f32x4 acc[8];
#pragma unroll
            for (int n = 0; n < 8; ++n) acc[n] = (f32x4){0.f, 0.f, 0.f, 0.f};
#pragma unroll
            for (int ks = 0; ks < 4; ++ks) if (ks < nks) { const int s0 = 32 * ks + 8 * fq;
                float wv[8] = {w0[ks][0], w0[ks][1], w0[ks][2], w0[ks][3], w1[ks][0], w1[ks][1], w1[ks][2], w1[ks][3]};
#pragma unroll
                for (int e = 0; e < 8; ++e) wv[e] = (s0 + e <= t) ? wv[e] : 0.f;
                u32x4 wp; wp.x = cvtpk2(wv[0], wv[1]); wp.y = cvtpk2(wv[2], wv[3]); wp.z = cvtpk2(wv[4], wv[5]); wp.w = cvtpk2(wv[6], wv[7]);
                const bf16x8 wf = *reinterpret_cast<bf16x8*>(&wp);
#pragma unroll
                for (int n = 0; n < 8; ++n) { const bf16x8 vf = *(const LAS bf16x8*)(VT + (16 * n + fr) * VT_STRIDE + s0);
                    acc[n] = __builtin_amdgcn_mfma_f32_16x16x32_bf16(vf, wf, acc[n], 0, 0, 0); } }
#pragma unroll
            for (int n = 0; n < 8; ++n) { const u32x2 a = au[n];
                const pg8::f32x2 u0 = pg8::gelu_pk((pg8::f32x2){bf_lo(a.x), bf_hi(a.x)}), u1 = pg8::gelu_pk((pg8::f32x2){bf_lo(a.y), bf_hi(a.y)});
                u32x2 o; o.x = cvtpk2(u0.x * (acc[n][0] + bias), u0.y * (acc[n][1] + bias)); o.y = cvtpk2(u1.x * (acc[n][2] + bias), u1.y * (acc[n][3] + bias));
                *(u32x2*)(AU + (size_t)(T0 + t) * WBR + g * 128 + 16 * n + 4 * fq) = o; }
        }
    }
    __syncthreads();
}

__device__ __forceinline__ void p3_merge(const bf16_t* __restrict__ proj, const bf16_t* __restrict__ OC, const float* __restrict__ lse, const float* __restrict__ ga, const float* __restrict__ gb,
                                          bf16_t* __restrict__ Y, int G) {
    const int lane = tidx() & 63, wid = tidx() >> 6;
    const bf16_t* YA = proj; const bf16_t* AZ = proj + 2 * SEG; const bf16_t* BZ = proj + 6 * SEG;
    for (int row = blockIdx.x * 8 + wid; row < M_TOK; row += G * 8) {
        float va[4][8], vb[4][8]; float ssa = 0.f, ssb = 0.f;
#pragma unroll
        for (int j = 0; j < 4; ++j) { const int c = 8 * (lane + 64 * j); const size_t o = (size_t)row * WBR + c;
            const u32x4 w = *(const u32x4*)(YA + o);
            va[j][0] = bf_lo(w.x); va[j][1] = bf_hi(w.x); va[j][2] = bf_lo(w.y); va[j][3] = bf_hi(w.y); va[j][4] = bf_lo(w.z); va[j][5] = bf_hi(w.z); va[j][6] = bf_lo(w.w); va[j][7] = bf_hi(w.w);
#pragma unroll
            for (int e = 0; e < 8; ++e) ssa += va[j][e] * va[j][e];
            const int h = c >> 7; const float l0 = lse[(size_t)row * 16 + h], l1 = lse[(size_t)(M_TOK + row) * 16 + h], l2 = lse[(size_t)(2 * M_TOK + row) * 16 + h];
            const float mx = fmaxf(l0, fmaxf(l1, l2)); const float e0 = __expf(l0 - mx), e1 = __expf(l1 - mx), e2 = __expf(l2 - mx); const float inv = 1.0f / (e0 + e1 + e2);
            const float a0 = e0 * inv, a1 = e1 * inv, a2 = e2 * inv;
            const u32x4 o0 = *(const u32x4*)(OC + o), o1 = *(const u32x4*)(OC + SEG + o), o2 = *(const u32x4*)(OC + 2 * SEG + o);
            vb[j][0] = a0 * bf_lo(o0.x) + a1 * bf_lo(o1.x) + a2 * bf_lo(o2.x); vb[j][1] = a0 * bf_hi(o0.x) + a1 * bf_hi(o1.x) + a2 * bf_hi(o2.x);
            vb[j][2] = a0 * bf_lo(o0.y) + a1 * bf_lo(o1.y) + a2 * bf_lo(o2.y); vb[j][3] = a0 * bf_hi(o0.y) + a1 * bf_hi(o1.y) + a2 * bf_hi(o2.y);
            vb[j][4] = a0 * bf_lo(o0.z) + a1 * bf_lo(o1.z) + a2 * bf_lo(o2.z); vb[j][5] = a0 * bf_hi(o0.z) + a1 * bf_hi(o1.z) + a2 * bf_hi(o2.z);
            vb[j][6] = a0 * bf_lo(o0.w) + a1 * bf_lo(o1.w) + a2 * bf_lo(o2.w); vb[j][7] = a0 * bf_hi(o0.w) + a1 * bf_hi(o1.w) + a2 * bf_hi(o2.w);
#pragma unroll
            for (int e = 0; e < 8; ++e) ssb += vb[j][e] * vb[j][e]; }
        ssa = wave_sum(ssa); ssb = wave_sum(ssb);
        const float rsa = __builtin_amdgcn_rsqf(ssa * (1.0f / WBR) + EPS), rsb = __builtin_amdgcn_rsqf(ssb * (1.0f / WBR) + EPS);
#pragma unroll
        for (int j = 0; j < 4; ++j) { const int c = 8 * (lane + 64 * j); const size_t o = (size_t)row * WBR + c;
            const u32x4 zar = *(const u32x4*)(AZ + o), zbr = *(const u32x4*)(BZ + o);
            float sa[8] = {bf_lo(zar.x), bf_hi(zar.x), bf_lo(zar.y), bf_hi(zar.y), bf_lo(zar.z), bf_hi(zar.z), bf_lo(zar.w), bf_hi(zar.w)};
            float sb[8] = {bf_lo(zbr.x), bf_hi(zbr.x), bf_lo(zbr.y), bf_hi(zbr.y), bf_lo(zbr.z), bf_hi(zbr.z), bf_lo(zbr.w), bf_hi(zbr.w)};
#pragma unroll
            for (int e = 0; e < 8; ++e) { sa[e] = sa[e] * pg8::sigmoidf_(sa[e]); sb[e] = sb[e] * pg8::sigmoidf_(sb[e]); }
            const f32x4 ga0 = *(const f32x4*)(ga + c), ga1 = *(const f32x4*)(ga + c + 4), gb0 = *(const f32x4*)(gb + c), gb1 = *(const f32x4*)(gb + c + 4);
            u32x4 wa, wb;
            wa.x = cvtpk2(va[j][0] * rsa * ga0[0] * sa[0], va[j][1] * rsa * ga0[1] * sa[1]); wa.y = cvtpk2(va[j][2] * rsa * ga0[2] * sa[2], va[j][3] * rsa * ga0[3] * sa[3]);
            wa.z = cvtpk2(va[j][4] * rsa * ga1[0] * sa[4], va[j][5] * rsa * ga1[1] * sa[5]); wa.w = cvtpk2(va[j][6] * rsa * ga1[2] * sa[6], va[j][7] * rsa * ga1[3] * sa[7]);
            wb.x = cvtpk2(vb[j][0] * rsb * gb0[0] * sb[0], vb[j][1] * rsb * gb0[1] * sb[1]); wb.y = cvtpk2(vb[j][2] * rsb * gb0[2] * sb[2], vb[j][3] * rsb * gb0[3] * sb[3]);
            wb.z = cvtpk2(vb[j][4] * rsb * gb1[0] * sb[4], vb[j][5] * rsb * gb1[1] * sb[5]); wb.w = cvtpk2(vb[j][6] * rsb * gb1[2] * sb[6], vb[j][7] * rsb * gb1[3] * sb[7]);
            *(u32x4*)(Y + (size_t)row * DM + c) = wa; *(u32x4*)(Y + (size_t)row * DM + WBR + c) = wb; }
    }
}
#ifndef PROBE_REP
#define PROBE_REP 0
#endif
#ifndef PROBE_IDLE_US
#define PROBE_IDLE_US 0
#endif
#ifndef PROBE_ATT_NOSTORE
#define PROBE_ATT_NOSTORE 0
#endif
#ifndef PROBE_NULLEPI
#define PROBE_NULLEPI 0
#endif
#define REPS(k) (((PROBE_REP >> (k)) & 1) ? 2 : 1)
__device__ __forceinline__ att::BlockRef<__hip_bfloat16, __hip_bfloat16> att_ref(int id, const bf16_t* proj, bf16_t* OC, float* lse, const float* relb) {
    id = id % 3072; const int cfg = id >> 10, rem = id & 1023, bh = rem >> 4, within = rem & 15, b = bh >> 4, h = bh & 15;
    const int dil = cfg == 0 ? 1 : (cfg == 1 ? 4 : 16), nqb = 16 / dil, r = within / nqb, qb = within % nqb;
    const size_t tok0 = (size_t)b * SEQ + r, tokq = tok0 + (size_t)(qb * 256) * dil;
    att::BlockRef<__hip_bfloat16, __hip_bfloat16> R;
    R.Q = (const __hip_bfloat16*)(proj + 3 * SEG + tokq * WBR + h * 128);
    R.K = (const __hip_bfloat16*)(proj + 4 * SEG + tok0 * WBR + h * 128);
    R.V = (const __hip_bfloat16*)(proj + 5 * SEG + tok0 * WBR + h * 128);
    R.O = (__hip_bfloat16*)(OC + (size_t)cfg * SEG + tokq * WBR + h * 128);
    R.LSE = lse + ((size_t)cfg * M_TOK + tokq) * 16 + h; R.RB = relb + h; R.P0 = qb * 256; R.RS = dil * WBR; R.dil = dil; R.flags = 0;
    return R;
}
__device__ __forceinline__ void p2_attention(const bf16_t* proj, bf16_t* OC, float* lse, const float* relb, int G, char* lds) {
    constexpr int NIT = 1024; typedef att::BlockRef<__hip_bfloat16, __hip_bfloat16> BR;
    const bool even = (NIT % G) == 0; const int run = even ? NIT / G : 0, nmine = even ? 3 * run * REPS(2) : (3 * NIT - (int)blockIdx.x + G - 1) / G;
    if (nmine <= 0) return;
#define ATT_ID(k_) (even ? ((((k_) / run) % 3) * NIT + (int)blockIdx.x * run + (k_) % run) : ((int)blockIdx.x + (k_) * G))
    int k = 0; BR cur = att_ref(ATT_ID(0), proj, OC, lse, relb);
    att::a2_lchar* ldsl = (att::a2_lchar*)lds_raw;
    att::Seam2 S;
    if (__builtin_amdgcn_readfirstlane(tidx() >> 6) >= 4) __builtin_amdgcn_s_setprio(1);
    att::a2_prime<__hip_bfloat16, __hip_bfloat16>(cur, 129, lds, ldsl, S);
    for (;;) {
        const bool last = k + 1 >= nmine;
        BR nxt = last ? cur : att_ref(ATT_ID(k + 1), proj, OC, lse, relb);
#if PROBE_ATT_NOSTORE
        if (k + 1 >= 3 * run) nxt.flags = 1;
#endif
        att::a2_block<__hip_bfloat16, __hip_bfloat16>(cur, nxt, 129, lds, ldsl, S);
        if (last) break;
        cur = nxt; ++k;
    }
    __builtin_amdgcn_s_setprio(0);
    asm volatile("s_waitcnt vmcnt(0) lgkmcnt(0)" ::: "memory"); __syncthreads();
#undef ATT_ID
}

#define XB_TMO      128
#define XB_XCNT(j)  (256  + 64 * (j))
#define XB_XSUB(j)  (1280 + 64 * (j))
#define XB_XGEN(j)  (2304 + 64 * (j))
#define XB_TOP      3328
#define XB_TOPGEN   3392
#define XCD_BAR_WORDS 3456
#define XB_SPIN_CAP (1u << 18)

__device__ __forceinline__ unsigned xb_ld(unsigned* p)              { return __hip_atomic_load(p, __ATOMIC_RELAXED, __HIP_MEMORY_SCOPE_AGENT); }
__device__ __forceinline__ unsigned xb_add(unsigned* p, unsigned v) { return __hip_atomic_fetch_add(p, v, __ATOMIC_RELAXED, __HIP_MEMORY_SCOPE_AGENT); }
__device__ __forceinline__ unsigned xb_xcc_id() { return (unsigned)__builtin_amdgcn_s_getreg((3 << 11) | 20) & 0xFu; }
#define XB_SPIN(cond, bar) do { unsigned _sp = 0; while (cond) { __builtin_amdgcn_s_sleep(1); \
    if ((++_sp & 255u) == 0u) { if (xb_ld(&(bar)[XB_TMO])) break; if (_sp > XB_SPIN_CAP) { atomicAdd(&(bar)[XB_TMO], 1u); break; } } } } while (0)

struct XcdBarrier {
    unsigned* bar; unsigned x;
    volatile LAS unsigned* st;
};

__device__ __forceinline__ XcdBarrier xcd_barrier_post(unsigned* bar, volatile LAS unsigned* st) {
    XcdBarrier b; b.bar = bar; b.x = xb_xcc_id(); b.st = st;
    if (tidx() == 0) (void)xb_add(&bar[XB_XCNT(b.x)], 1u);
    return b;
}
__device__ __forceinline__ void xcd_barrier_complete(unsigned* bar, unsigned x, unsigned& nloc, unsigned& nx) {
    const unsigned G = gridDim.x * gridDim.y * gridDim.z;
    unsigned sum, cnt, mine, sp = 0u;
    for (;;) {
        sum = 0u; cnt = 0u; mine = 0u;
#pragma unroll
        for (unsigned j = 0; j < 16; ++j) { const unsigned c = xb_ld(&bar[XB_XCNT(j)]); sum += c; cnt += (c > 0u) ? 1u : 0u; mine = (j == x) ? c : mine; }
        if (sum == G) break;
        __builtin_amdgcn_s_sleep(1);
        if ((++sp & 255u) == 0u) { if (xb_ld(&bar[XB_TMO])) break; if (sp > XB_SPIN_CAP) { atomicAdd(&bar[XB_TMO], 1u); break; } }
    }
    nloc = mine > 0u ? mine : 1u; nx = cnt > 0u ? cnt : 1u;
}

__device__ __forceinline__ void xcd_barrier(const XcdBarrier& b) {
    asm volatile("s_waitcnt vmcnt(0)" ::: "memory");
    __syncthreads();
    if (tidx() == 0) {
        unsigned* bar = b.bar;
        __builtin_amdgcn_s_waitcnt(0);
        unsigned nloc = b.st[0], nx = b.st[1];
        if (nloc == 0u) { xcd_barrier_complete(bar, b.x, nloc, nx); b.st[0] = nloc; b.st[1] = nx; }
        const unsigned old = xb_add(&bar[XB_XSUB(b.x)], 1u);
        const unsigned gen = old / nloc;
        if (old + 1u == (gen + 1u) * nloc) {
            __builtin_amdgcn_fence(__ATOMIC_RELEASE, "agent");
            asm volatile("s_waitcnt vmcnt(0)" ::: "memory");
            const unsigned og = xb_add(&bar[XB_TOP], 1u);
            const unsigned tg = og / nx;
            if (og + 1u == (tg + 1u) * nx) xb_add(&bar[XB_TOPGEN], 1u);
            else XB_SPIN(xb_ld(&bar[XB_TOPGEN]) == tg, bar);
            __builtin_amdgcn_fence(__ATOMIC_ACQUIRE, "agent");
            xb_add(&bar[XB_XGEN(b.x)], 1u);
            asm volatile("s_waitcnt vmcnt(0)" ::: "memory");
        } else {
            XB_SPIN(xb_ld(&bar[XB_XGEN(b.x)]) == gen, bar);
            __builtin_amdgcn_fence(__ATOMIC_ACQUIRE, "agent");
            asm volatile("s_waitcnt vmcnt(0)" ::: "memory");
        }
    }
    __syncthreads();
}
__device__ __forceinline__ void grid_barrier(unsigned* ctr, unsigned target) {
    asm volatile("s_waitcnt vmcnt(0) lgkmcnt(0)" ::: "memory");
    __syncthreads();
    if (tidx() == 0) {
        __builtin_amdgcn_fence(__ATOMIC_RELEASE, "agent");
        asm volatile("s_waitcnt vmcnt(0)" ::: "memory");
        __hip_atomic_fetch_add(ctr, 1u, __ATOMIC_RELAXED, __HIP_MEMORY_SCOPE_AGENT);
        while (__hip_atomic_load(ctr, __ATOMIC_RELAXED, __HIP_MEMORY_SCOPE_AGENT) < target) __builtin_amdgcn_s_sleep(2);
        __builtin_amdgcn_fence(__ATOMIC_ACQUIRE, "agent");
        asm volatile("s_waitcnt vmcnt(0)" ::: "memory");
    }
    __syncthreads();
}
struct Params { const float* in[17]; float* out; unsigned char* ws; int ph_lo, ph_hi; };
constexpr int NPHASE = 6;
__global__ void __launch_bounds__(512, 2) hybrid_layer_fwd(Params P) {
    LAS unsigned char* lds = (LAS unsigned char*)lds_raw;
    { const int t0 = (int)__builtin_amdgcn_workitem_id_x(); if ((t0 & 63) == 0) ((LAS int*)(lds + LDS_WTAB))[hw_slot()] = t0 >> 6; __syncthreads(); }
    cg::grid_group grid = cg::this_grid();
    const int G = gridDim.x, lo = P.ph_lo, hi = P.ph_hi;
    unsigned char* ws = P.ws;
    const float* x = P.in[0]; const float* p = P.in[1]; const float* g_pre = P.in[2]; const float* w_in = P.in[3]; const float* w_s = P.in[4]; const float* b_s = P.in[5];
    const float* ln_v_g = P.in[6]; const float* ln_v_b = P.in[7]; const float* g_q = P.in[8]; const float* g_k = P.in[9]; const float* rel_bias = P.in[10];
    const float* g_out_a = P.in[11]; const float* g_out_b = P.in[12]; const float* w_out = P.in[13]; const float* g_ple = P.in[14]; const float* w_gate = P.in[15]; const float* w_up = P.in[16];
    bf16_t* HN = (bf16_t*)(ws + WS_HN); bf16_t* WIN = (bf16_t*)(ws + WS_WIN); bf16_t* WOUT = (bf16_t*)(ws + WS_WOUT); bf16_t* WG = (bf16_t*)(ws + WS_WG); bf16_t* WUP = (bf16_t*)(ws + WS_WUP);
    bf16_t* PB = (bf16_t*)(ws + WS_PB); float* LNP = (float*)(ws + WS_LNP); float* HSQ = (float*)(ws + WS_HSQ); float* LSE = (float*)(ws + WS_LSE);
    bf16_t* PROJ = (bf16_t*)(ws + WS_PROJ); bf16_t* OC = (bf16_t*)(ws + WS_OC); bf16_t* HB = (bf16_t*)(ws + WS_HB); bf16_t* UB = (bf16_t*)(ws + WS_UB);
#define IN_PH(k) (lo <= (k) && (k) < hi)
    unsigned* CTL = (unsigned*)(ws + WS_CTL);
    XcdBarrier xbar; xbar.bar = CTL + 1024; xbar.x = 0; xbar.st = (volatile LAS unsigned*)(lds + LDS_XB);
    if (lo == 0 && hi == NPHASE) { if (tidx() < 2) ((LAS unsigned*)(lds + LDS_XB))[tidx()] = 0u; __syncthreads(); xbar = xcd_barrier_post(CTL + 1024, (volatile LAS unsigned*)(lds + LDS_XB)); }
    if (lo < 0) grid.sync();
#define SEAM(k) do { if (lo <= (k) && (k) + 1 < hi) xcd_barrier(xbar); } while (0)

    if (IN_PH(0)) for (int rep_ = 0; rep_ < REPS(0); ++rep_) {
        p0_rmsnorm_x(x, g_pre, HN, G);
        p0_convert_p(p, PB, G);
        p0_weights(w_in, w_out, w_gate, g_ple, w_up, WIN, WOUT, WG, WUP, G, lds);
    }
    SEAM(0);
    if (IN_PH(1)) for (int rep_ = 0; rep_ < REPS(1); ++rep_) {
        pg8::Gemm g{HN, WIN, M_TOK, DIN, DM}; pg8::StaticOrder S; S.init(M_TOK, DIN, G, (int)blockIdx.x);
        pg8::EpiProj E{PROJ, LNP, g_q, g_k, (LAS float*)(lds + LDS_X)};
        pg8::gemm_phase<pg8::EpiProj, pg8::StaticOrder>(lds, g, S, E, nullptr);
#if PROBE_NULLEPI == 1
        { pg8::EpiNull E0{LNP}; pg8::gemm_phase<pg8::EpiNull, pg8::StaticOrder>(lds, g, S, E0, nullptr); }
#endif
    }
    SEAM(1);
#if PROBE_IDLE_US
    { const unsigned long long t0_ = __builtin_amdgcn_s_memrealtime();
      while (__builtin_amdgcn_s_memrealtime() - t0_ < (unsigned long long)(PROBE_IDLE_US * 100)) __builtin_amdgcn_s_sleep(64); }
#endif
    if (IN_PH(2)) {
        p2_attention(PROJ, OC, LSE, rel_bias, G, (char*)lds_raw);
        p2_gmlp(PROJ, PROJ + SEG, LNP, ln_v_g, ln_v_b, w_s, b_s, G, lds);
    }
    SEAM(2);
    if (IN_PH(3)) for (int rep_ = 0; rep_ < REPS(3); ++rep_) p3_merge(PROJ, OC, LSE, g_out_a, g_out_b, HN, G);
    SEAM(3);
    if (IN_PH(4)) for (int rep_ = 0; rep_ < REPS(4); ++rep_) {
        { pg8::Gemm g{PB, WUP, M_TOK, DM, DPLE}; pg8::StaticOrder S; S.init(M_TOK, DM, G, (int)blockIdx.x);
          pg8::EpiU E{UB};
          for (int r2_ = 0; r2_ < REPS(6); ++r2_) pg8::gemm_phase<pg8::EpiU, pg8::StaticOrder>(lds, g, S, E, nullptr); }
        { pg8::Gemm g{HN, WOUT, M_TOK, DM, DM}; pg8::StaticOrder S; S.init(M_TOK, DM, G, (int)blockIdx.x);
          pg8::EpiH E{x, HB, HSQ};
          pg8::gemm_phase<pg8::EpiH, pg8::StaticOrder>(lds, g, S, E, nullptr); }
    }
    SEAM(4);
    if (IN_PH(5)) for (int rep_ = 0; rep_ < REPS(5); ++rep_) {
        pg8::Gemm g{HB, WG, M_TOK, DM, DM}; pg8::RsOrder S; S.init(M_TOK, DM, G, (int)blockIdx.x); S.hsq = HSQ; S.RS = (LAS float*)(lds + LDS_RS);
        pg8::EpiOut E{HB, UB, P.out, (LAS float*)(lds + LDS_RS)};
        pg8::gemm_phase<pg8::EpiOut, pg8::RsOrder>(lds, g, S, E, nullptr);
    }
#undef IN_PH
#undef SEAM
}

#ifndef MK_LAUNCHES
#define MK_LAUNCHES 1
#endif
extern "C" void kernel_launch(void* const* d_in, const int* in_sizes, int n_in, void* d_out, int out_size, void* d_ws, size_t ws_size, hipStream_t stream) {
    static int grid = 0;
    if (grid == 0) {
        if (n_in != 17 || out_size != M_TOK * DM || ws_size < WS_END) { fprintf(stderr, "kernel_launch: unexpected shapes (n_in %d out %d ws %zu)\n", n_in, out_size, ws_size); grid = -1; return; }
        if (hipFuncSetAttribute((const void*)hybrid_layer_fwd, hipFuncAttributeMaxDynamicSharedMemorySize, LDS_BYTES) != hipSuccess) { fprintf(stderr, "kernel_launch: hipFuncSetAttribute failed\n"); grid = -1; return; }
        int dev = 0, cus = 0, per_cu = 0;
        (void)hipGetDevice(&dev); (void)hipDeviceGetAttribute(&cus, hipDeviceAttributeMultiprocessorCount, dev);
        if (hipOccupancyMaxActiveBlocksPerMultiprocessor(&per_cu, (const void*)hybrid_layer_fwd, 512, LDS_BYTES) != hipSuccess || per_cu < 1) { fprintf(stderr, "kernel_launch: occupancy query says %d blocks/CU\n", per_cu); per_cu = 1; }
        (void)hipGetLastError();
        grid = cus > 0 ? cus : 256;
    }
    if (grid < 0) return;
    (void)hipMemsetAsync((unsigned char*)d_ws + WS_CTL, 0, 32768, stream);
    Params P{};
    for (int i = 0; i < 17; ++i) P.in[i] = (const float*)d_in[i];
    P.out = (float*)d_out; P.ws = (unsigned char*)d_ws;
#if MK_LAUNCHES == 1
    P.ph_lo = 0; P.ph_hi = NPHASE;
    void* args[] = {&P};
    hipError_t e = hipLaunchCooperativeKernel((const void*)hybrid_layer_fwd, dim3(grid), dim3(512), args, LDS_BYTES, stream);
    if (e != hipSuccess) fprintf(stderr, "kernel_launch: cooperative launch failed: %s (grid %d)\n", hipGetErrorString(e), grid);
#else
    for (int ph = 0; ph < NPHASE; ++ph) { P.ph_lo = ph; P.ph_hi = ph + 1;
        hipLaunchKernelGGL(hybrid_layer_fwd, dim3(grid), dim3(512), LDS_BYTES, stream, P); }
#endif
}
```

```cpp
#include <hip/hip_runtime.h>
#include <hip/hip_bf16.h>
#include <hip/hip_cooperative_groups.h>
#include <cstdio>
#include <cstdint>
namespace cg = cooperative_groups;
#define LAS __attribute__((address_space(3)))

constexpr int M_TOK = 16384, DM = 4096, DIN = 14336, WBR = 2048, SEQ = 4096, NBATCH = 4, NHEAD = 16, DPLE = 256;
constexpr float EPS = 1e-6f;
constexpr size_t MiB = 1024ull * 1024ull;
constexpr size_t WS_HN = 0;
constexpr size_t WS_WIN = 128 * MiB;
constexpr size_t WS_WOUT = 240 * MiB;
constexpr size_t WS_WG = 272 * MiB;
constexpr size_t WS_WUP = 304 * MiB;
constexpr size_t WS_PB = 306 * MiB;
constexpr size_t WS_LNP = 314 * MiB;
constexpr size_t WS_HSQ = 318 * MiB;
constexpr size_t WS_LSE = 322 * MiB;
constexpr size_t WS_CTL = 326 * MiB;
constexpr size_t WS_PROJ = 330 * MiB;
constexpr size_t WS_OC = 778 * MiB;
constexpr size_t WS_HB = 330 * MiB;
constexpr size_t WS_UB = 458 * MiB;
constexpr size_t WS_END = 970 * MiB;
constexpr size_t SEG = (size_t)M_TOK * WBR;
constexpr int LDS_STAGE = 131072, LDS_X = 131072  , LDS_RS = LDS_X + 8192  , LDS_WTAB = 156160  , LDS_XB = LDS_WTAB + 256  , LDS_BYTES = LDS_XB + 16;
extern __shared__ __attribute__((aligned(16))) unsigned char lds_raw[];
__device__ __forceinline__ int hw_slot() { unsigned v; asm volatile("s_getreg_b32 %0, hwreg(HW_REG_HW_ID, 0, 6)" : "=s"(v)); return (int)v; }
__device__ __forceinline__ int tidx() {
    const int w = __builtin_amdgcn_readfirstlane(((const LAS int*)((LAS unsigned char*)lds_raw + LDS_WTAB))[hw_slot()]);
    unsigned l; asm volatile("v_mbcnt_lo_u32_b32 %0, -1, 0\n\tv_mbcnt_hi_u32_b32 %0, -1, %0" : "=v"(l));
    return w * 64 + (int)l;
}
namespace pg8 {
#define PG8_LAS __attribute__((address_space(3)))
typedef unsigned short bf16_t;
typedef short bf16x8 __attribute__((ext_vector_type(8)));
typedef float f32x4 __attribute__((ext_vector_type(4)));
typedef unsigned u32x4 __attribute__((ext_vector_type(4)));
constexpr int BM = 256, BK = 64, HALF = 128, HTB = HALF * BK * 2  , STAGE_BYTES = 8 * HTB, NXCD = 8, WGM = 8;

__host__ __device__ __forceinline__ int lds_byte(int r, int c) { const int st = (r >> 4) * 2 + (c >> 5), rr = r & 15, cc = c & 31, ob = rr * 64 + cc * 2; return st * 1024 + (ob ^ (((ob >> 9) & 1) << 5)); }
__host__ __device__ __forceinline__ void stage_rc(int b, int& R, int& C) { const int st = b / 1024, sb = b % 1024, swz = sb ^ (((sb >> 9) & 1) << 5); R = (st >> 1) * 16 + swz / 64; C = (st & 1) * 32 + (swz % 64) / 2; }
__host__ __device__ __forceinline__ int perm32(int rho) { const int n = rho >> 4, i = rho & 15; return 8 * (i >> 2) + 4 * n + (i & 3); }

struct Unit { int pm, pn; };
struct Gemm { const bf16_t* A; const bf16_t* Bt; int M, N, K; };

struct StaticOrder {
    int nM, nN, nwg, G, c;
    __host__ __device__ void init(int M, int N, int G_, int c_) { nM = M / BM; nN = N / BM; nwg = nM * nN; G = G_; c = c_; }
    __host__ __device__ bool next(int i, Unit& u) const {
        const long L = (long)i * G + c; if (L >= nwg) return false;
        int wgid = (int)L; { const int q = nwg / NXCD, r = nwg % NXCD, xcd = wgid % NXCD, off = wgid / NXCD; wgid = (xcd < r ? xcd * (q + 1) : r * (q + 1) + (xcd - r) * q) + off; }
        const int nig = WGM * nN, gid = wgid / nig, fm = gid * WGM, gsz = (nM - fm) < WGM ? (nM - fm) : WGM;
        u.pm = fm + ((wgid % nig) % gsz); u.pn = (wgid % nig) / gsz; return true;
    }
    __device__ __forceinline__ void a_ready(const Unit&, int) const {}
    __device__ __forceinline__ void done(const Unit&) const {}
};
}
namespace pg8 {
__device__ __forceinline__ unsigned cvt_pk_bf16(float lo, float hi) { unsigned r; asm volatile("v_cvt_pk_bf16_f32 %0, %1, %2" : "=v"(r) : "v"(lo), "v"(hi)); return r; }
typedef float f32x2 __attribute__((ext_vector_type(2)));
__device__ __forceinline__ f32x2 gelu_pk(f32x2 v) {
    const f32x2 av = __builtin_elementwise_abs(v), d = av * 0.2316418882f + 1.0f;
    f32x2 t; t.x = __builtin_amdgcn_rcpf(d.x); t.y = __builtin_amdgcn_rcpf(d.y);
    f32x2 q = t * 0.5307027145f + (-0.7265760135f); q = q * t + 0.7107068705f; q = q * t + (-0.142248368f); q = q * t + 0.127414796f; q = q * t;
    const f32x2 s = (v * v) * (-0.72134752044f);
    f32x2 e; e.x = __builtin_amdgcn_exp2f(s.x); e.y = __builtin_amdgcn_exp2f(s.y);
    const f32x2 m = v * (q * e), r = v - m;
    f32x2 o; o.x = v.x < 0.f ? m.x : r.x; o.y = v.y < 0.f ? m.y : r.y; return o;
}
}
namespace pg8 {
__device__ __forceinline__ float sigmoidf_(float v) { return __builtin_amdgcn_rcpf(1.0f + __builtin_amdgcn_exp2f(-1.4426950408889634f * v)); }
__device__ __forceinline__ f32x4 gelu4(f32x4 v) { const f32x2 a = gelu_pk((f32x2){v[0], v[1]}), b = gelu_pk((f32x2){v[2], v[3]}); return (f32x4){a.x, a.y, b.x, b.y}; }
__device__ __forceinline__ f32x4 silu4(f32x4 v) { return (f32x4){v[0] * sigmoidf_(v[0]), v[1] * sigmoidf_(v[1]), v[2] * sigmoidf_(v[2]), v[3] * sigmoidf_(v[3])}; }
__device__ __forceinline__ float sq4(f32x4 v) { return (v[0] * v[0] + v[1] * v[1]) + (v[2] * v[2] + v[3] * v[3]); }
__device__ __forceinline__ float sum4(f32x4 v) { return (v[0] + v[1]) + (v[2] + v[3]); }

struct EpiProj {
    static constexpr bool PERM = true, AFTER_DRAIN = false;
    bf16_t* proj; float* lnp; const float* gq; const float* gk; PG8_LAS float* X;
    __device__ __forceinline__ void operator()(const f32x4 (&acc)[2][2][4][2], const Unit& u, int ui, int wr, int wc, int fr, int fq) const {
        const int seg = __builtin_amdgcn_readfirstlane(u.pn >> 3), ct = __builtin_amdgcn_readfirstlane(u.pn & 7);
        const int row0 = u.pm * BM + wr * 64 + fr, col0 = ct * 256 + wc * 64 + 8 * fq;
        bf16_t* base = proj + (size_t)seg * SEG;
        if (seg == 3 || seg == 4) {
#pragma unroll
            for (int ai = 0; ai < 2; ++ai)
#pragma unroll
                for (int m = 0; m < 4; ++m)
#pragma unroll
                    for (int bj = 0; bj < 2; ++bj) {
                        float s = sq4(acc[ai][bj][m][0]) + sq4(acc[ai][bj][m][1]);
                        s += __shfl_xor(s, 16); s += __shfl_xor(s, 32);
                        if (fq == 0) X[((ai * HALF + wr * 64 + m * 16 + fr) * 2 + (wc >> 1)) * 4 + (wc & 1) * 2 + bj] = s;
                    }
            asm volatile("s_waitcnt lgkmcnt(0)" ::: "memory"); __builtin_amdgcn_s_barrier(); asm volatile("" ::: "memory");
            const float* gv = (seg == 3 ? gq : gk) + (wc & 1) * 64 + 8 * fq;
            const f32x4 g00 = *(const f32x4*)gv, g01 = *(const f32x4*)(gv + 4), g10 = *(const f32x4*)(gv + 32), g11 = *(const f32x4*)(gv + 36);
            const float sc = seg == 3 ? 0.08838834764831845f : 1.0f;
#pragma unroll
            for (int ai = 0; ai < 2; ++ai)
#pragma unroll
                for (int m = 0; m < 4; ++m) { bf16_t* rowp = base + (size_t)(row0 + ai * HALF + m * 16) * WBR + col0;
#pragma unroll
                    for (int bj = 0; bj < 2; ++bj) {
                        const f32x4 p = *(const PG8_LAS f32x4*)(X + ((ai * HALF + wr * 64 + m * 16 + fr) * 2 + (wc >> 1)) * 4);
                        const float rs = __builtin_amdgcn_rsqf(((p[0] + p[1]) + (p[2] + p[3])) * (1.0f / 128.0f) + EPS) * sc;
                        const f32x4 v0 = acc[ai][bj][m][0] * rs * (bj ? g10 : g00), v1 = acc[ai][bj][m][1] * rs * (bj ? g11 : g01);
                        u32x4 w; w.x = cvt_pk_bf16(v0[0], v0[1]); w.y = cvt_pk_bf16(v0[2], v0[3]); w.z = cvt_pk_bf16(v1[0], v1[1]); w.w = cvt_pk_bf16(v1[2], v1[3]);
                        *(u32x4*)(rowp + bj * 32) = w; } }
        } else {
#pragma unroll
            for (int ai = 0; ai < 2; ++ai)
#pragma unroll
                for (int m = 0; m < 4; ++m) { bf16_t* rowp = base + (size_t)(row0 + ai * HALF + m * 16) * WBR + col0; float s1 = 0.f, s2 = 0.f;
#pragma unroll
                    for (int bj = 0; bj < 2; ++bj) { f32x4 v0 = acc[ai][bj][m][0], v1 = acc[ai][bj][m][1];
                        if (seg == 1) { v0 = gelu4(v0); v1 = gelu4(v1); }
                        if (seg == 1) { s1 += sum4(v0) + sum4(v1); s2 += sq4(v0) + sq4(v1); }
                        u32x4 w; w.x = cvt_pk_bf16(v0[0], v0[1]); w.y = cvt_pk_bf16(v0[2], v0[3]); w.z = cvt_pk_bf16(v1[0], v1[1]); w.w = cvt_pk_bf16(v1[2], v1[3]);
                        if (seg == 5) *(u32x4*)(rowp + bj * 32) = w; else __builtin_nontemporal_store(w, (u32x4*)(rowp + bj * 32)); }
                    if (seg == 1) { s1 += __shfl_xor(s1, 16); s1 += __shfl_xor(s1, 32); s2 += __shfl_xor(s2, 16); s2 += __shfl_xor(s2, 32);
                        if (fq == 0) *(f32x2*)(lnp + ((size_t)(row0 + ai * HALF + m * 16) * 32 + ct * 4 + wc) * 2) = (f32x2){s1, s2}; } }
        }
    }
};
struct EpiNull {
    static constexpr bool PERM = true, AFTER_DRAIN = false;
    float* sink;
    __device__ __forceinline__ void operator()(const f32x4 (&acc)[2][2][4][2], const Unit& u, int ui, int wr, int wc, int fr, int fq) const {
        float s = 0.f;
#pragma unroll
        for (int ai = 0; ai < 2; ++ai)
#pragma unroll
            for (int bj = 0; bj < 2; ++bj)
#pragma unroll
                for (int m = 0; m < 4; ++m)
#pragma unroll
                    for (int n = 0; n < 2; ++n) s += sum4(acc[ai][bj][m][n]);
        if (s == 123.456f) sink[0] = s;
    }
};
struct EpiH {
    static constexpr bool PERM = true, AFTER_DRAIN = false;
    const float* x; bf16_t* HB; float* hsq;
    __device__ __forceinline__ void operator()(const f32x4 (&acc)[2][2][4][2], const Unit& u, int ui, int wr, int wc, int fr, int fq) const {
        const int row0 = u.pm * BM + wr * 64 + fr, col0 = u.pn * BM + wc * 64 + 8 * fq;
#pragma unroll
        for (int ai = 0; ai < 2; ++ai)
#pragma unroll
            for (int m = 0; m < 4; ++m) { const int row = row0 + ai * HALF + m * 16; const size_t off = (size_t)row * DM + col0; float s = 0.f;
#pragma unroll
                for (int bj = 0; bj < 2; ++bj) { const f32x4 h0 = *(const f32x4*)(x + off + bj * 32) + acc[ai][bj][m][0], h1 = *(const f32x4*)(x + off + bj * 32 + 4) + acc[ai][bj][m][1];
                    s += sq4(h0) + sq4(h1);
                    u32x4 w; w.x = cvt_pk_bf16(h0[0], h0[1]); w.y = cvt_pk_bf16(h0[2], h0[3]); w.z = cvt_pk_bf16(h1[0], h1[1]); w.w = cvt_pk_bf16(h1[2], h1[3]);
                    *(u32x4*)(HB + off + bj * 32) = w; }
                s += __shfl_xor(s, 16); s += __shfl_xor(s, 32);
                if (fq == 0) hsq[(size_t)row * 64 + u.pn * 4 + wc] = s;
                if (m == 3) asm volatile("" ::: "memory"); }
    }
};
struct EpiU {
    static constexpr bool PERM = true, AFTER_DRAIN = false;
    bf16_t* U;
    __device__ __forceinline__ void operator()(const f32x4 (&acc)[2][2][4][2], const Unit& u, int ui, int wr, int wc, int fr, int fq) const {
        const int row0 = u.pm * BM + wr * 64 + fr, col0 = u.pn * BM + wc * 64 + 8 * fq;
#pragma unroll
        for (int ai = 0; ai < 2; ++ai)
#pragma unroll
            for (int m = 0; m < 4; ++m) { bf16_t* rowp = U + (size_t)(row0 + ai * HALF + m * 16) * DM + col0;
#pragma unroll
                for (int bj = 0; bj < 2; ++bj) { const f32x4 a = acc[ai][bj][m][0], b = acc[ai][bj][m][1];
                    u32x4 w; w.x = cvt_pk_bf16(a[0], a[1]); w.y = cvt_pk_bf16(a[2], a[3]); w.z = cvt_pk_bf16(b[0], b[1]); w.w = cvt_pk_bf16(b[2], b[3]);
                    *(u32x4*)(rowp + bj * 32) = w; } }
    }
};
struct EpiOut {
    static constexpr bool PERM = true, AFTER_DRAIN = false;
    const bf16_t* HB; const bf16_t* U; float* out; PG8_LAS float* RS; int selm;
    __device__ __forceinline__ void operator()(const f32x4 (&acc)[2][2][4][2], const Unit& u, int ui, int wr, int wc, int fr, int fq) const {
        const int row0 = u.pm * BM + wr * 64 + fr, col0 = u.pn * BM + wc * 64 + 8 * fq;
#pragma unroll
        for (int ai = 0; ai < 2; ++ai)
#pragma unroll
            for (int m = 0; m < 4; ++m) { const size_t off = (size_t)(row0 + ai * HALF + m * 16) * DM + col0; const float rs = RS[(ui & selm) * 256 + ai * HALF + wr * 64 + m * 16 + fr];
#pragma unroll
                for (int bj = 0; bj < 2; ++bj) { const u32x4 hw = *(const u32x4*)(HB + off + bj * 32), uw = *(const u32x4*)(U + off + bj * 32);
                    const f32x4 a = acc[ai][bj][m][0] * rs, b = acc[ai][bj][m][1] * rs; f32x4 o0, o1;
                    o0[0] = __uint_as_float(hw.x << 16) + sigmoidf_(a[0]) * __uint_as_float(uw.x << 16); o0[1] = __uint_as_float(hw.x & 0xffff0000u) + sigmoidf_(a[1]) * __uint_as_float(uw.x & 0xffff0000u);
                    o0[2] = __uint_as_float(hw.y << 16) + sigmoidf_(a[2]) * __uint_as_float(uw.y << 16); o0[3] = __uint_as_float(hw.y & 0xffff0000u) + sigmoidf_(a[3]) * __uint_as_float(uw.y & 0xffff0000u);
                    o1[0] = __uint_as_float(hw.z << 16) + sigmoidf_(b[0]) * __uint_as_float(uw.z << 16); o1[1] = __uint_as_float(hw.z & 0xffff0000u) + sigmoidf_(b[1]) * __uint_as_float(uw.z & 0xffff0000u);
                    o1[2] = __uint_as_float(hw.w << 16) + sigmoidf_(b[2]) * __uint_as_float(uw.w << 16); o1[3] = __uint_as_float(hw.w & 0xffff0000u) + sigmoidf_(b[3]) * __uint_as_float(uw.w & 0xffff0000u);
                    __builtin_nontemporal_store(o0, (f32x4*)(out + off + bj * 32)); __builtin_nontemporal_store(o1, (f32x4*)(out + off + bj * 32 + 4)); }
                if (m == 3) asm volatile("" ::: "memory"); }
    }
};
struct SameUnitOrder {
    int n;
    __device__ __forceinline__ bool next(int i, Unit& u) const { if (i >= n) return false; u.pm = 0; u.pn = 0; return true; }
    __device__ __forceinline__ void a_ready(const Unit&, int) const {}
    __device__ __forceinline__ void done(const Unit&) const {}
};
struct RsOrder : StaticOrder {
    const float* hsq; PG8_LAS float* RS; int selm;
    __device__ __forceinline__ void a_ready(const Unit& u, int ui) const {
        if (selm == 0 && ui > 0) return;
        const int row = tidx() >> 1, half = tidx() & 1; const float* p = hsq + (size_t)(u.pm * BM + row) * 64 + half * 32; float s = 0.f;
#pragma unroll
        for (int i = 0; i < 8; ++i) s += sum4(*(const f32x4*)(p + 4 * i));
        s += __shfl_xor(s, 1);
        if (half == 0) RS[(ui & selm) * 256 + row] = __builtin_amdgcn_rsqf(s * (1.0f / 4096.0f) + EPS);
    }
};
}
namespace pg8 {
#ifndef PG8_ALIGN_EPI
#define PG8_ALIGN_EPI 1
#endif
#ifndef PG8_SP2
#define PG8_SP2 1
#endif
template <class Epi, class Sched, bool STAMP = false>
__device__ __forceinline__ void gemm_phase(PG8_LAS unsigned char* lds, const Gemm g, const Sched& S, const Epi& E, unsigned long long* stamps) {
    const int tid = tidx(), wid = __builtin_amdgcn_readfirstlane(tid >> 6), lane = tid & 63, wr = wid >> 2, wc = wid & 3, fr = lane & 15, fq = lane >> 4;
    const int K = g.K, nt = K / BK; constexpr bool ALIGN_EPI = PG8_ALIGN_EPI != 0, SP2 = PG8_SP2 != 0;
    int ts_lo = 0, ts_hi = 0, nts = 0; const unsigned long long rt_entry = STAMP ? (unsigned long long)wall_clock64() : 0ull;
#define PG8_STAMP() do { if (STAMP && wid == 0 && nts < 64) { const unsigned long long _c = (unsigned long long)clock64(); \
        ts_lo = (lane == nts) ? (int)(unsigned)_c : ts_lo; ts_hi = (lane == nts) ? (int)(unsigned)(_c >> 32) : ts_hi; ++nts; } } while (0)
    PG8_STAMP();
    unsigned voffA[2], voffB0[2];
#pragma unroll
    for (int i = 0; i < 2; ++i) { int R, C; stage_rc(tid * 16 + i * 8192, R, C);
        voffA[i] = (unsigned)(R * K + C) * 2u;
        if (Epi::PERM) { const int Rb = 64 * (R >> 5) + perm32(R & 31);
            voffB0[i] = (unsigned)(Rb * K + C) * 2u; }
        else { voffB0[i] = (unsigned)(R * K + C) * 2u; } }
    const size_t kstep = (size_t)(BK * 2);
    const size_t hstep = (size_t)HALF * K * 2;
    const size_t tstep = 2 * hstep;
    const size_t bh1 = Epi::PERM ? (size_t)32 * K * 2 : hstep;
    const unsigned ldsw = (unsigned)wid * 1024u;
    const int aoff = lds_byte(wr * 64 + fr, fq * 8), boff = lds_byte(wc * 32 + fr, fq * 8);
#define PG8_SA(b, h) (((b) * 2 + (h)) * HTB)
#define PG8_SB(b, h) ((4 + (b) * 2 + (h)) * HTB)
#define PG8_STAGE(bufoff, gbase, voff) do { _Pragma("unroll") for (int _i = 0; _i < 2; ++_i) \
        __builtin_amdgcn_global_load_lds((const unsigned*)((const char*)(gbase) + (voff)[_i]), (PG8_LAS unsigned*)(lds + (bufoff) + ldsw + _i * 8192), 16, 0, 0); } while (0)
#define PG8_LDA(dst, b, h) do { _Pragma("unroll") for (int m = 0; m < 4; ++m) _Pragma("unroll") for (int k = 0; k < 2; ++k) dst[m][k] = *(const PG8_LAS bf16x8*)(lds + PG8_SA(b, h) + aoff + m * 2048 + k * 1024); } while (0)
#define PG8_LDB(dst, b, h) do { _Pragma("unroll") for (int n = 0; n < 2; ++n) _Pragma("unroll") for (int k = 0; k < 2; ++k) dst[n][k] = *(const PG8_LAS bf16x8*)(lds + PG8_SB(b, h) + boff + n * 2048 + k * 1024); } while (0)
#define PG8_MMA(ai, bj, At, Bt) do { __builtin_amdgcn_s_setprio(1); _Pragma("unroll") for (int m = 0; m < 4; ++m) _Pragma("unroll") for (int n = 0; n < 2; ++n) _Pragma("unroll") for (int k = 0; k < 2; ++k) \
        acc[ai][bj][m][n] = __builtin_amdgcn_mfma_f32_16x16x32_bf16(Bt[n][k], At[m][k], acc[ai][bj][m][n], 0, 0, 0); __builtin_amdgcn_s_setprio(0); } while (0)
#define PG8_WAIT_V(n) asm volatile("s_waitcnt vmcnt(" #n ")" ::: "memory")
#define PG8_WAIT_L(n) asm volatile("s_waitcnt lgkmcnt(" #n ")" ::: "memory")
#define PG8_BAR __builtin_amdgcn_s_barrier()
#define PG8_SCHED __builtin_amdgcn_sched_barrier(0)
    Unit cur, nxt; int ui = 0;
    if (!S.next(0, cur)) return;
    f32x4 acc[2][2][4][2];
#pragma unroll
    for (int a = 0; a < 2; ++a)
#pragma unroll
        for (int b = 0; b < 2; ++b)
#pragma unroll
            for (int m = 0; m < 4; ++m)
#pragma unroll
                for (int n = 0; n < 2; ++n) acc[a][b][m][n] = (f32x4){0.f, 0.f, 0.f, 0.f};
    bf16x8 At[4][2], B0[2][2], B1[2][2];
    const char* cA = (const char*)g.A + (size_t)cur.pm * tstep; const char* cB = (const char*)g.Bt + (size_t)cur.pn * tstep;
    S.a_ready(cur, 0);
    if constexpr (SP2) {
        PG8_STAGE(PG8_SB(0, 0), cB, voffB0); PG8_STAGE(PG8_SB(0, 1), cB + bh1, voffB0); PG8_STAGE(PG8_SA(0, 0), cA, voffA); PG8_STAGE(PG8_SA(0, 1), cA + hstep, voffA);
        if (wr == 1) PG8_BAR;
        PG8_WAIT_V(2); PG8_BAR;
        PG8_STAGE(PG8_SB(1, 0), cB + kstep, voffB0); PG8_STAGE(PG8_SA(1, 0), cA + kstep, voffA); PG8_STAGE(PG8_SB(1, 1), cB + kstep + bh1, voffB0);
        PG8_WAIT_V(6); PG8_BAR;
    } else {
    PG8_STAGE(PG8_SB(0, 0), cB, voffB0); PG8_STAGE(PG8_SA(0, 0), cA, voffA); PG8_STAGE(PG8_SB(0, 1), cB + bh1, voffB0); PG8_STAGE(PG8_SA(0, 1), cA + hstep, voffA);
    if (wr == 1) PG8_BAR;
    PG8_WAIT_V(4); PG8_BAR;
    PG8_STAGE(PG8_SB(1, 0), cB + kstep, voffB0); PG8_STAGE(PG8_SA(1, 0), cA + kstep, voffA); PG8_STAGE(PG8_SB(1, 1), cB + kstep + bh1, voffB0);
    PG8_WAIT_V(6); PG8_BAR;
    }
    PG8_STAMP();
    for (;;) {
        const bool has_next = S.next(ui + 1, nxt);
        const char* nA = has_next ? (const char*)g.A + (size_t)nxt.pm * tstep : cA; const char* nB = has_next ? (const char*)g.Bt + (size_t)nxt.pn * tstep : cB;
        for (int t = 0; t < nt; t += 2) {
            const bool last = (t == nt - 2);
            const char* a1 = cA + (size_t)(t + 1) * kstep;
            const char* a2 = last ? nA : cA + (size_t)(t + 2) * kstep; const char* b2 = last ? nB : cB + (size_t)(t + 2) * kstep;
            const char* a3 = a2 + kstep; const char* b3 = b2 + kstep;
            if (last && has_next) S.a_ready(nxt, ui + 1);
            if constexpr (SP2) {
            PG8_LDB(B0, 0, 0); PG8_LDB(B1, 0, 1); PG8_SCHED; PG8_LDA(At, 0, 0); PG8_STAGE(PG8_SA(1, 1), a1 + hstep, voffA);
            PG8_WAIT_V(8); PG8_WAIT_L(0); PG8_BAR; PG8_MMA(0, 0, At, B0); PG8_MMA(0, 1, At, B1); PG8_BAR; PG8_SCHED;
            PG8_LDA(At, 0, 1); PG8_STAGE(PG8_SB(0, 0), b2, voffB0); PG8_STAGE(PG8_SB(0, 1), b2 + bh1, voffB0); PG8_STAGE(PG8_SA(0, 0), a2, voffA);
            PG8_WAIT_V(8); PG8_WAIT_L(0); PG8_BAR; PG8_MMA(1, 0, At, B0); PG8_MMA(1, 1, At, B1); PG8_BAR; PG8_SCHED;
            PG8_LDB(B0, 1, 0); PG8_LDB(B1, 1, 1); PG8_SCHED; PG8_LDA(At, 1, 0); PG8_STAGE(PG8_SA(0, 1), a2 + hstep, voffA);
            PG8_WAIT_V(8); PG8_WAIT_L(0); PG8_BAR; PG8_MMA(0, 0, At, B0); PG8_MMA(0, 1, At, B1); PG8_BAR; PG8_SCHED;
            PG8_LDA(At, 1, 1); PG8_STAGE(PG8_SB(1, 0), b3, voffB0); PG8_STAGE(PG8_SB(1, 1), b3 + bh1, voffB0); PG8_STAGE(PG8_SA(1, 0), a3, voffA);
            PG8_WAIT_V(8); PG8_WAIT_L(0); PG8_BAR; PG8_MMA(1, 0, At, B0); PG8_MMA(1, 1, At, B1); PG8_BAR; PG8_SCHED;
            } else {
            PG8_LDB(B0, 0, 0); PG8_SCHED; PG8_LDA(At, 0, 0); PG8_STAGE(PG8_SA(1, 1), a1 + hstep, voffA);
            PG8_WAIT_L(8); PG8_BAR; PG8_WAIT_L(0); PG8_MMA(0, 0, At, B0); PG8_BAR; PG8_SCHED;
            PG8_LDB(B1, 0, 1); PG8_STAGE(PG8_SB(0, 0), b2, voffB0);
            PG8_BAR; PG8_WAIT_L(0); PG8_MMA(0, 1, At, B1); PG8_BAR;
            PG8_LDA(At, 0, 1); PG8_STAGE(PG8_SA(0, 0), a2, voffA);
            PG8_BAR; PG8_WAIT_L(0); PG8_MMA(1, 0, At, B0); PG8_BAR; PG8_SCHED;
            PG8_STAGE(PG8_SB(0, 1), b2 + bh1, voffB0);
            PG8_WAIT_V(6); PG8_BAR; PG8_MMA(1, 1, At, B1); PG8_BAR;
            PG8_LDB(B0, 1, 0); PG8_SCHED; PG8_LDA(At, 1, 0); PG8_STAGE(PG8_SA(0, 1), a2 + hstep, voffA);
            PG8_WAIT_L(8); PG8_BAR; PG8_WAIT_L(0); PG8_MMA(0, 0, At, B0); PG8_BAR; PG8_SCHED;
            PG8_LDB(B1, 1, 1); PG8_STAGE(PG8_SB(1, 0), b3, voffB0);
            PG8_BAR; PG8_WAIT_L(0); PG8_MMA(0, 1, At, B1); PG8_BAR;
            PG8_LDA(At, 1, 1); PG8_STAGE(PG8_SA(1, 0), a3, voffA);
            PG8_BAR; PG8_WAIT_L(0); PG8_MMA(1, 0, At, B0); PG8_BAR; PG8_SCHED;
            PG8_STAGE(PG8_SB(1, 1), b3 + bh1, voffB0);
            PG8_WAIT_V(6); PG8_BAR; PG8_MMA(1, 1, At, B1); PG8_BAR;
            }
        }
        PG8_STAMP();
        if constexpr (ALIGN_EPI) { if (wr == 0) PG8_BAR; }
        if constexpr (!Epi::AFTER_DRAIN) { E(acc, cur, ui, wr, wc, fr, fq); S.done(cur); }
        PG8_STAMP();
        if (!has_next) break;
#pragma unroll
        for (int a = 0; a < 2; ++a)
#pragma unroll
            for (int b = 0; b < 2; ++b)
#pragma unroll
                for (int m = 0; m < 4; ++m)
#pragma unroll
                    for (int n = 0; n < 2; ++n) acc[a][b][m][n] = (f32x4){0.f, 0.f, 0.f, 0.f};
        cur = nxt; cA = nA; cB = nB; ++ui;
        if constexpr (ALIGN_EPI) { if (wr == 1) PG8_BAR; }
    }
    PG8_WAIT_V(0);
    if constexpr (!ALIGN_EPI) { if (wr == 0) PG8_BAR; }
    PG8_BAR;
    if constexpr (Epi::AFTER_DRAIN) { E.fused(acc, cur, wr, wc, fr, fq, lds, wid, lane); S.done(cur); }
    PG8_STAMP();
    if (STAMP && wid == 0) { stamps[lane] = lane < nts ? (((unsigned long long)(unsigned)ts_hi << 32) | (unsigned)ts_lo) : 0ull;
        if (lane == 62) stamps[62] = rt_entry; if (lane == 63) stamps[63] = (unsigned long long)wall_clock64(); }
#undef PG8_STAMP
#undef PG8_SA
#undef PG8_SB
#undef PG8_STAGE
#undef PG8_LDA
#undef PG8_LDB
#undef PG8_MMA
#undef PG8_WAIT_V
#undef PG8_WAIT_L
#undef PG8_BAR
#undef PG8_SCHED
}
}
namespace att {
constexpr int D = 128; constexpr float THR = 8.f; constexpr bool WSKIP = true;
constexpr float SCALE = 1.0f;
constexpr int NW = 8, QBLK = 32, KVBLK = 64, QB = NW * QBLK;
constexpr int SHM_V = KVBLK * D * 2, SHM_K = KVBLK * D * 2;
constexpr int LDS_BYTES = 2 * SHM_V + 2 * SHM_K + NW * 64 * 4;
constexpr int BT_OFF = LDS_BYTES, BT_N = 320, BT_ZERO = 96;

using bf16 = __hip_bfloat16;
typedef short bf16x8 __attribute__((ext_vector_type(8)));
typedef short s16x4 __attribute__((ext_vector_type(4)));
typedef float f32x16 __attribute__((ext_vector_type(16)));
typedef float f32x4 __attribute__((ext_vector_type(4)));
typedef unsigned u32x4 __attribute__((ext_vector_type(4)));
template <class A, class Bt> struct same_t { static constexpr bool v = false; };
template <class A> struct same_t<A, A> { static constexpr bool v = true; };

#define KSWZ(row, colB) ((row) * 256 + ((colB) ^ (((row) & 7) << 4)))
#define SBAR() __builtin_amdgcn_sched_barrier(0)
__device__ __forceinline__ int v_st(int k, int c) { const int kk = (k & ~0xC) | ((k & 4) << 1) | ((k & 8) >> 1); return ((kk >> 3) * 4 + (c >> 5)) * 512 + ((kk & 7) * 32 + (c & 31)) * 2; }
__device__ __forceinline__ int v_rd_base(int lane) { return ((lane & 3) << 3) | (((lane >> 2) & 3) << 6) | (((lane >> 4) & 1) << 5) | (((lane >> 5) & 1) << 8); }
constexpr int v_rd_off(int d0, int ks, int half) { return d0 * 512 + ks * 4096 + half * 2048; }
__device__ __forceinline__ int crow(int r, int hi) { return (r & 3) + 8 * (r >> 2) + 4 * hi; }
__device__ __forceinline__ unsigned cvtpk(float lo, float hi) {
    unsigned r; asm volatile("v_cvt_pk_bf16_f32 %0, %1, %2" : "=v"(r) : "v"(lo), "v"(hi)); return r;
}
__device__ __forceinline__ bf16x8 pack8(f32x4 a, f32x4 b) {
    u32x4 w = {cvtpk(a[0], a[1]), cvtpk(a[2], a[3]), cvtpk(b[0], b[1]), cvtpk(b[2], b[3])};
    return *reinterpret_cast<bf16x8*>(&w);
}
template <class T> __device__ __forceinline__ bf16x8 load8(const T* p) {
    if constexpr (same_t<T, float>::v) { return pack8(*(const f32x4*)p, *(const f32x4*)(p + 4)); }
    else { return *reinterpret_cast<const bf16x8*>(p); }
}
__device__ __forceinline__ void mask_tile(f32x16& p0, f32x16& p1, int dq, unsigned W, const float* bt) {
    const float NEG = -__builtin_inff();
    const float* b = bt + (dq + BT_ZERO - 64);
#pragma unroll
    for (int r = 0; r < 16; ++r) {
        const int c = (r & 3) + 8 * (r >> 2);
        const float b0 = b[64 - c], b1 = b[32 - c];
        p0[r] = ((unsigned)(dq - c) >= W) ? NEG : p0[r] + b0;
        p1[r] = ((unsigned)(dq - c - 32) >= W) ? NEG : p1[r] + b1;
    }
}
__device__ __forceinline__ void partialSM(f32x16& p0, f32x16& p1, float& m_reg, float& mn, float& alpha) {
    float pmax = p0[0]; for (int r = 1; r < 16; ++r) pmax = fmaxf(pmax, p0[r]); for (int r = 0; r < 16; ++r) pmax = fmaxf(pmax, p1[r]);
    { auto rr = __builtin_amdgcn_permlane32_swap(__float_as_uint(pmax), __float_as_uint(pmax), false, false);
      pmax = fmaxf(__uint_as_float(rr[0]), __uint_as_float(rr[1])); }
    constexpr float C2 = 1.4426950408889634f * SCALE;
    if (__builtin_expect(__all((pmax - m_reg) * SCALE <= THR), 1)) { mn = m_reg; alpha = 1.f; }
    else { mn = fmaxf(m_reg, pmax); alpha = __builtin_amdgcn_exp2f((m_reg - mn) * C2); m_reg = mn; }
    const float mnL = -mn * C2;
    for (int r = 0; r < 16; ++r) p0[r] = fmaf(p0[r], C2, mnL); for (int r = 0; r < 16; ++r) p1[r] = fmaf(p1[r], C2, mnL);
    for (int r = 0; r < 16; ++r) p0[r] = __builtin_amdgcn_exp2f(p0[r]);
}
__device__ __forceinline__ void finishSM(f32x16& p0, f32x16& p1, float alpha, float& l_reg, bf16x8& pa0, bf16x8& pa1, bf16x8& pa2, bf16x8& pa3) {
    for (int r = 0; r < 16; ++r) p1[r] = __builtin_amdgcn_exp2f(p1[r]);
    float ps = 0; for (int r = 0; r < 16; ++r) ps += p0[r]; for (int r = 0; r < 16; ++r) ps += p1[r];
    { auto rr = __builtin_amdgcn_permlane32_swap(__float_as_uint(ps), __float_as_uint(ps), false, false);
      ps = __uint_as_float(rr[0]) + __uint_as_float(rr[1]); }
    l_reg = l_reg * alpha + ps;
#define PK4(P, B_, OUT) do { unsigned a0 = cvtpk(P[B_+0], P[B_+1]), a1 = cvtpk(P[B_+2], P[B_+3]);                          \
        unsigned b0 = cvtpk(P[B_+4], P[B_+5]), b1 = cvtpk(P[B_+6], P[B_+7]);                                             \
        auto r0 = __builtin_amdgcn_permlane32_swap(a0, b0, false, false); auto r1 = __builtin_amdgcn_permlane32_swap(a1, b1, false, false); \
        u32x4 w = {r0[0], r1[0], r0[1], r1[1]}; OUT = *reinterpret_cast<bf16x8*>(&w); } while (0)
    PK4(p0, 0, pa0); PK4(p0, 8, pa1); PK4(p1, 0, pa2); PK4(p1, 8, pa3);
#undef PK4
}
template <int KB, bool SK>
__device__ __forceinline__ void qkt(f32x16& p0, f32x16& p1, const char* K_lds, int r32, int hi, const bf16x8* qr, bool act) {
    if (SK && !act) { const float NEG = -__builtin_inff();
#pragma unroll
        for (int r = 0; r < 16; ++r) { p0[r] = NEG; p1[r] = NEG; } return; }
    p0 = f32x16{}; p1 = f32x16{};
    const char* kb[4];
#pragma unroll
    for (int dd = 0; dd < 4; ++dd) kb[dd] = K_lds + KB * SHM_K + KSWZ(r32, (dd * 16 + hi * 8) * 2);
#pragma unroll
    for (int d0 = 0; d0 < 8; ++d0) { const char* a = kb[d0 & 3] + (d0 >> 2) * 128;
        bf16x8 b0 = *reinterpret_cast<const bf16x8*>(a);
        bf16x8 b1 = *reinterpret_cast<const bf16x8*>(a + 32 * 256);
        p0 = __builtin_amdgcn_mfma_f32_32x32x16_bf16(b0, qr[d0], p0, 0, 0, 0);
        p1 = __builtin_amdgcn_mfma_f32_32x32x16_bf16(b1, qr[d0], p1, 0, 0, 0); }
}
template <int VB, bool SK>
__device__ __forceinline__ void pv_tile(f32x16* o, int vb0, bf16x8 pa0, bf16x8 pa1, bf16x8 pa2, bf16x8 pa3, bool act) {
    if (SK && !act) return;
#define TRRD(dst, off) asm volatile("ds_read_b64_tr_b16 %0, %1 offset:%2" : "=&v"(dst) : "v"(vb0), "i"(off) : "memory")
#define PV_D0(d0) do { s16x4 l0, l1, l2, l3, h0, h1, h2, h3; constexpr int b_ = VB * SHM_V + v_rd_off(d0, 0, 0);     \
        TRRD(l0, b_); TRRD(h0, b_ + 2048); TRRD(l1, b_ + 4096); TRRD(h1, b_ + 6144); TRRD(l2, b_ + 8192); TRRD(h2, b_ + 10240); TRRD(l3, b_ + 12288); TRRD(h3, b_ + 14336); \
        asm volatile("s_waitcnt lgkmcnt(0)" ::: "memory"); SBAR();                 \
        o[d0] = __builtin_amdgcn_mfma_f32_32x32x16_bf16(pa0, (bf16x8){l0[0], l0[1], l0[2], l0[3], h0[0], h0[1], h0[2], h0[3]}, o[d0], 0, 0, 0);   \
        o[d0] = __builtin_amdgcn_mfma_f32_32x32x16_bf16(pa1, (bf16x8){l1[0], l1[1], l1[2], l1[3], h1[0], h1[1], h1[2], h1[3]}, o[d0], 0, 0, 0);   \
        o[d0] = __builtin_amdgcn_mfma_f32_32x32x16_bf16(pa2, (bf16x8){l2[0], l2[1], l2[2], l2[3], h2[0], h2[1], h2[2], h2[3]}, o[d0], 0, 0, 0);   \
        o[d0] = __builtin_amdgcn_mfma_f32_32x32x16_bf16(pa3, (bf16x8){l3[0], l3[1], l3[2], l3[3], h3[0], h3[1], h3[2], h3[3]}, o[d0], 0, 0, 0); } while (0)
    PV_D0(0); PV_D0(1); PV_D0(2); PV_D0(3);
#undef PV_D0
#undef TRRD
}

template <class TIn, class TOut> struct BlockRef { const TIn* Q; const TIn* K; const TIn* V; TOut* O; float* LSE; const float* RB; int P0; int RS; int dil; int flags; };
template <class TIn> struct Seam {
    int par;
    bf16x8 qr[8];
    bf16x8 st_v0, st_v1, st_k0, st_k1; f32x4 sf0, sf1, sf2, sf3;
    f32x4 tq[16];
};
__device__ __forceinline__ int swa_jlo(int P0, int W) { const int lowk = P0 - W + 1; return lowk > 0 ? lowk / KVBLK : 0; }
#define ROW(p, k0, rr) ((p) + (size_t)((k0) + (rr)) * RSX + sc)
#define VMW() asm volatile("s_waitcnt vmcnt(0)" ::: "memory")
#define VMWN(n) asm volatile("s_waitcnt vmcnt(%0)" :: "i"(n) : "memory")
#define SLOAD_H(Kp, Vp, k0) do { S.st_v0 = load8<TIn>(ROW(Vp, k0, sr)); S.st_v1 = load8<TIn>(ROW(Vp, k0, 32 + sr));              \
                         S.st_k0 = load8<TIn>(ROW(Kp, k0, sr)); S.st_k1 = load8<TIn>(ROW(Kp, k0, 32 + sr)); } while (0)
#define SWRITE_HK(bf) do { *(bf16x8*)(K_lds + (bf) * SHM_K + kws) = S.st_k0; *(bf16x8*)(K_lds + (bf) * SHM_K + kws + 32 * 256) = S.st_k1; } while (0)
#define SWRITE_HV(bf) do { *(bf16x8*)(V_lds + (bf) * SHM_V + vst0) = S.st_v0; *(bf16x8*)(V_lds + (bf) * SHM_V + vst1) = S.st_v1; } while (0)
#define SWRITE_H(bf) do { SWRITE_HV(bf); SWRITE_HK(bf); } while (0)
#define SLOAD_F(p, k0) do { S.sf0 = *(const f32x4*)ROW(p, k0, sr); S.sf1 = *(const f32x4*)(ROW(p, k0, sr) + 4);                \
                            S.sf2 = *(const f32x4*)ROW(p, k0, 32 + sr); S.sf3 = *(const f32x4*)(ROW(p, k0, 32 + sr) + 4); } while (0)
#define SWRITE_KF(bf) do { *(bf16x8*)(K_lds + (bf) * SHM_K + kws) = pack8(S.sf0, S.sf1); *(bf16x8*)(K_lds + (bf) * SHM_K + kws + 32 * 256) = pack8(S.sf2, S.sf3); } while (0)
#define SWRITE_VF(bf) do { *(bf16x8*)(V_lds + (bf) * SHM_V + vst0) = pack8(S.sf0, S.sf1); *(bf16x8*)(V_lds + (bf) * SHM_V + vst1) = pack8(S.sf2, S.sf3); } while (0)
__device__ __forceinline__ void fill_bias(float* tbl, const float* RB, int dil) {
    const int tid = tidx();
    if (tid < BT_N) { const int delta = tid - BT_ZERO; float v = 0.f;
        if (delta >= 0 && delta <= 128) { const int dist = delta * dil; int bk;
            if (dist < 16) bk = dist; else { const float d = (float)dist; const int lg = 16 + (int)(logf(d / 16.0f) / 4.852030263919617f * 16.0f); bk = lg < 31 ? lg : 31; }
            v = RB[bk * 16]; }
        tbl[tid] = v; }
}
template <class TIn, class TOut>
__device__ __forceinline__ void causal_swa_prime(const BlockRef<TIn, TOut>& cur, int W, char* lds, Seam<TIn>& S) {
    constexpr bool F32 = same_t<TIn, float>::v;
    const int tid = tidx(), wid = __builtin_amdgcn_readfirstlane(tid >> 6), lane = tid & 63, r32 = lane & 31, hi = lane >> 5;
    const int sr = tid >> 4, sc = (tid & 15) * 8, kws = KSWZ(sr, sc * 2); char* K_lds = lds + 2 * SHM_V;
    const int kb0 = swa_jlo(cur.P0, W) * KVBLK; const int RSX = cur.RS;
    S.par = 0; fill_bias((float*)(lds + BT_OFF), cur.RB, cur.dil);
    for (int d0 = 0; d0 < 8; ++d0) S.qr[d0] = load8<TIn>(cur.Q + (size_t)(wid * QBLK + r32) * cur.RS + d0 * 16 + hi * 8);
    if constexpr (F32) { SLOAD_F((const float*)cur.K, kb0); VMW(); SWRITE_KF(0); SBAR(); SLOAD_F((const float*)cur.V, kb0); }
    else { SLOAD_H(cur.K, cur.V, kb0); VMW(); SWRITE_HK(0); }
    __syncthreads();
}
template <class TIn, class TOut>
__device__ __forceinline__ void causal_swa_block(const BlockRef<TIn, TOut>& cur, const BlockRef<TIn, TOut>& nxt, int skv, int W, char* lds, Seam<TIn>& S) {
    constexpr bool F32 = same_t<TIn, float>::v;
    const int tid = tidx(), wid = __builtin_amdgcn_readfirstlane(tid >> 6), lane = tid & 63, r32 = lane & 31, hi = lane >> 5;
    const int j_lo = swa_jlo(cur.P0, W); int RSX = cur.RS;
    const float* bt = (const float*)(lds + BT_OFF) + S.par * BT_N;
    int j_hi = (cur.P0 + QB - 1) / KVBLK + 1; if (j_hi > skv / KVBLK) j_hi = skv / KVBLK;
    const int NT = j_hi - j_lo;
    const int kbn = swa_jlo(nxt.P0, W) * KVBLK;
    const int qlo = cur.P0 + wid * QBLK, qm = qlo + r32 - 4 * hi;
    char* V_lds = lds; char* K_lds = lds + 2 * SHM_V;
    float* ws = (float*)(lds + 2 * SHM_V + 2 * SHM_K) + wid * 64; float* li_l = ws, * al_l = ws + 32;
    float m_reg = -1e30f, l_reg = 0; f32x16 o[4] = {};
    const int sr = tid >> 4, sc = (tid & 15) * 8, vst0 = v_st(sr, sc), vst1 = v_st(32 + sr, sc), kws = KSWZ(sr, sc * 2);
    const int vb0 = (int)(uintptr_t)V_lds + v_rd_base(lane);
    const TIn* Kh = cur.K; const TIn* Vh = cur.V;
#define RESC(a) do { if (__any((a) < 1.f)) { if (hi == 0) al_l[r32] = (a); asm volatile("s_waitcnt lgkmcnt(0)" ::: "memory");              \
                     for (int d_ = 0; d_ < 4; ++d_) for (int r = 0; r < 16; ++r) o[d_][r] *= al_l[crow(r, hi)]; } } while (0)
#define KBASE(t) ((j_lo + (t)) * KVBLK)
#define ACT(t) (KBASE(t) <= qlo + QBLK - 1 && KBASE(t) + KVBLK - 1 >= qlo - W + 1)
#define MASKT(P0_, P1_, t) do { const int kb_ = KBASE(t); if (!SK || ACT(t)) mask_tile(P0_, P1_, qm - kb_, (unsigned)W, bt); } while (0)
    constexpr int NQL = F32 ? 16 : 8;
    constexpr bool SK = WSKIP && !F32;
#define SEAM_K0() do { VMWN(NQL); if constexpr (F32) { SWRITE_KF(0); SBAR(); SLOAD_F((const float*)nxt.V, kbn); } else { SWRITE_HK(0); } SBAR(); } while (0)
    f32x16 pA0, pA1, pB0, pB1; float mnA, mnB, alA, alB; bf16x8 pa0, pa1, pa2, pa3;
    if constexpr (F32) { VMW(); SWRITE_VF(0); SBAR(); } else { SWRITE_HV(0); SBAR(); }
    if (NT > 1) { if constexpr (F32) SLOAD_F((const float*)Kh, KBASE(1)); else SLOAD_H(Kh, Vh, KBASE(1)); }
    SBAR(); qkt<0, SK>(pA0, pA1, K_lds, r32, hi, S.qr, ACT(0));
    if constexpr (F32) { if (NT > 1) { VMW(); SWRITE_KF(1); SBAR(); SLOAD_F((const float*)Vh, KBASE(1)); } }
    MASKT(pA0, pA1, 0); partialSM(pA0, pA1, m_reg, mnA, alA);
    if (NT > 1) { VMW(); if constexpr (F32) { SWRITE_VF(1); SBAR(); if (NT > 2) SLOAD_F((const float*)Kh, KBASE(2)); } else SWRITE_H(1); }
    __syncthreads();
#define HALF_STEP(PX0, PX1, mnX, alX, PY0, PY1, alY, t, KB, VB, SB) do {                                                      \
        SBAR(); qkt<KB, SK>(PX0, PX1, K_lds, r32, hi, S.qr, ACT(t));                                             \
        finishSM(PY0, PY1, alY, l_reg, pa0, pa1, pa2, pa3); SBAR();                                                           \
        if ((t) + 1 < NT) { if constexpr (F32) { VMW(); SWRITE_KF(SB); SBAR(); SLOAD_F((const float*)Vh, KBASE((t) + 1)); }  \
                            else { SLOAD_H(Kh, Vh, KBASE((t) + 1)); } SBAR(); }                                               \
        pv_tile<VB, SK>(o, vb0, pa0, pa1, pa2, pa3, ACT((t) - 1)); MASKT(PX0, PX1, (t)); partialSM(PX0, PX1, m_reg, mnX, alX);                                        \
        __syncthreads();                                                                                                      \
        if ((t) + 1 < NT) { VMW(); if constexpr (F32) { SWRITE_VF(SB); SBAR(); if ((t) + 2 < NT) SLOAD_F((const float*)Kh, KBASE((t) + 2)); } \
                            else { SWRITE_H(SB); } }                                                                          \
        RESC(alX); __syncthreads(); } while (0)
    for (int t = 1; t + 1 < NT; t += 2) {
        HALF_STEP(pB0, pB1, mnB, alB, pA0, pA1, alA, t, 1, 0, 0);
        HALF_STEP(pA0, pA1, mnA, alA, pB0, pB1, alB, t + 1, 0, 1, 1);
    }
    const bool even = (NT & 1) == 0;
    if (even) { SBAR(); qkt<1, SK>(pB0, pB1, K_lds, r32, hi, S.qr, ACT(NT - 1)); SBAR(); }
#define QROW(e) (nxt.Q + (size_t)(wid * QBLK + r32) * nxt.RS + ((e) >> 1) * 16 + hi * 8 + ((e) & 1) * 4)
    RSX = nxt.RS;
    if constexpr (F32) { SLOAD_F((const float*)nxt.K, kbn); SBAR();
#pragma unroll
        for (int e = 0; e < 8; ++e) S.tq[e] = *(const f32x4*)QROW(e); }
    else { SLOAD_H(nxt.K, nxt.V, kbn); SBAR();
#pragma unroll
        for (int d0 = 0; d0 < 8; ++d0) S.qr[d0] = load8<TIn>(nxt.Q + (size_t)(wid * QBLK + r32) * nxt.RS + d0 * 16 + hi * 8); }
    SBAR();
    finishSM(pA0, pA1, alA, l_reg, pa0, pa1, pa2, pa3); SBAR();
    if constexpr (F32) {
#pragma unroll
        for (int e = 8; e < 16; ++e) S.tq[e] = *(const f32x4*)QROW(e); SBAR(); }
#undef QROW
    pv_tile<0, SK>(o, vb0, pa0, pa1, pa2, pa3, ACT(even ? NT - 2 : NT - 1));
    if (even) { MASKT(pB0, pB1, NT - 1); partialSM(pB0, pB1, m_reg, mnB, alB); __syncthreads(); RESC(alB);
        finishSM(pB0, pB1, alB, l_reg, pa0, pa1, pa2, pa3); SBAR(); pv_tile<1, SK>(o, vb0, pa0, pa1, pa2, pa3, ACT(NT - 1)); }
    SBAR(); SEAM_K0();
    if (hi == 0) { li_l[r32] = l_reg; cur.LSE[(size_t)(wid * QBLK + r32) * (size_t)(16 * cur.dil)] = m_reg * SCALE + __logf(l_reg); }
    fill_bias((float*)(lds + BT_OFF) + (S.par ^ 1) * BT_N, nxt.RB, nxt.dil); S.par ^= 1;
    asm volatile("s_waitcnt lgkmcnt(0)" ::: "memory");
    float rli[16];
#pragma unroll
    for (int r = 0; r < 16; ++r) rli[r] = __builtin_amdgcn_rcpf(li_l[crow(r, hi)]);
    TOut* Ow = cur.O + (size_t)(wid * QBLK) * cur.RS + (size_t)(4 * hi) * cur.RS;
#pragma unroll
    for (int r = 0; r < 16; ++r) { const int orow = (r & 3) + 8 * (r >> 2);
#pragma unroll
        for (int d0 = 0; d0 < 4; ++d0) { const float v = o[d0][r] * rli[r];
            if constexpr (same_t<TOut, float>::v) { Ow[(size_t)orow * cur.RS + d0 * 32 + r32] = v; }
            else { const float vn = __shfl_xor(v, 1);
                   if ((r32 & 1) == 0) *(unsigned*)(Ow + (size_t)orow * cur.RS + d0 * 32 + r32) = cvtpk(v, vn); } } }
    if constexpr (F32) {
#pragma unroll
        for (int d0 = 0; d0 < 8; ++d0) S.qr[d0] = pack8(S.tq[2 * d0], S.tq[2 * d0 + 1]); }
    __syncthreads();
#undef RESC
#undef KBASE
#undef ACT
#undef MASKT
#undef SEAM_K0
#undef HALF_STEP
}
#undef ROW
#undef VMW
#undef VMWN
#undef SLOAD_H
#undef SWRITE_HK
#undef SWRITE_HV
#undef SWRITE_H
#undef SLOAD_F
#undef SWRITE_KF
#undef SWRITE_VF
constexpr int A2_V = 0, A2_K = 4 * SHM_V, A2_WS = A2_K + 4 * SHM_K, A2_BT = A2_WS + NW * 64 * 4, A2_OST = A2_BT + 2 * BT_N * 4  , A2_BYTES = A2_OST + NW * 2560;
struct Seam2 { int par; int g; bf16x8 qr[8]; };
typedef __attribute__((address_space(3))) char a2_lchar;
#define A2_VMW() asm volatile("s_waitcnt vmcnt(0)" ::: "memory")
#define A2_VMWN(n) asm volatile("s_waitcnt vmcnt(%0)" :: "i"(n) : "memory")
#define A2_BAR() do { asm volatile("s_waitcnt lgkmcnt(0)" ::: "memory"); __builtin_amdgcn_s_barrier(); asm volatile("" ::: "memory"); } while (0)
#define A2_GLDS(Kp, Vp, rs, k0, b) do { const size_t rs_ = (size_t)(rs);                                                                              \
        const __hip_bfloat16* kp_ = (Kp) + (size_t)(k0) * rs_ + (size_t)sr * rs_ + ckK; const __hip_bfloat16* vp_ = (Vp) + (size_t)(k0) * rs_ + (size_t)kV * rs_ + ckV;           \
        a2_lchar* kd_ = ldsl + A2_K + (b) * SHM_K + wid * 1024; a2_lchar* vd_ = ldsl + A2_V + (b) * SHM_V + wid * 1024;                                  \
        __builtin_amdgcn_global_load_lds((const unsigned*)kp_, (__attribute__((address_space(3))) unsigned*)kd_, 16, 0, 0);                              \
        __builtin_amdgcn_global_load_lds((const unsigned*)(kp_ + 32 * rs_), (__attribute__((address_space(3))) unsigned*)(kd_ + 8192), 16, 0, 0);          \
        __builtin_amdgcn_global_load_lds((const unsigned*)vp_, (__attribute__((address_space(3))) unsigned*)vd_, 16, 0, 0);                              \
        __builtin_amdgcn_global_load_lds((const unsigned*)(vp_ + 32 * rs_), (__attribute__((address_space(3))) unsigned*)(vd_ + 8192), 16, 0, 0); } while (0)
#define A2_LANE_CONSTS() const int tid = tidx(), wid = __builtin_amdgcn_readfirstlane(tid >> 6), lane = tid & 63, r32 = lane & 31, hi = lane >> 5;            \
    const int sr = tid >> 4, ckK = ((tid & 15) ^ (sr & 7)) * 8;                                                                                           \
    const int kkV = ((tid >> 7) << 3) | ((tid & 31) >> 2), kV = (kkV & ~0xC) | ((kkV & 4) << 1) | ((kkV & 8) >> 1), ckV = (((tid >> 5) & 3) << 5) | ((tid & 3) << 3)

template <bool SK>
__device__ __forceinline__ void qkt2(f32x16& p0, f32x16& p1, const char* Kt, int r32, int hi, const bf16x8* qr, bool act) {
    if (SK && !act) { const float NEG = -__builtin_inff();
#pragma unroll
        for (int r = 0; r < 16; ++r) { p0[r] = NEG; p1[r] = NEG; } return; }
    p0 = f32x16{}; p1 = f32x16{};
    const char* kb[4];
#pragma unroll
    for (int dd = 0; dd < 4; ++dd) kb[dd] = Kt + KSWZ(r32, (dd * 16 + hi * 8) * 2);
#pragma unroll
    for (int d0 = 0; d0 < 8; ++d0) { const char* a = kb[d0 & 3] + (d0 >> 2) * 128;
        bf16x8 b0 = *reinterpret_cast<const bf16x8*>(a);
        bf16x8 b1 = *reinterpret_cast<const bf16x8*>(a + 32 * 256);
        p0 = __builtin_amdgcn_mfma_f32_32x32x16_bf16(b0, qr[d0], p0, 0, 0, 0);
        p1 = __builtin_amdgcn_mfma_f32_32x32x16_bf16(b1, qr[d0], p1, 0, 0, 0); }
}
template <bool SK>
__device__ __forceinline__ void pv2(f32x16* o, int vbx, bf16x8 pa0, bf16x8 pa1, bf16x8 pa2, bf16x8 pa3, bool act) {
    if (SK && !act) return;
#define TRRD(dst, off) asm volatile("ds_read_b64_tr_b16 %0, %1 offset:%2" : "=&v"(dst) : "v"(vbx), "i"(off) : "memory")
#define PV_D0(d0) do { s16x4 l0, l1, l2, l3, h0, h1, h2, h3; constexpr int b_ = v_rd_off(d0, 0, 0);                                                     \
        TRRD(l0, b_); TRRD(h0, b_ + 2048); TRRD(l1, b_ + 4096); TRRD(h1, b_ + 6144); TRRD(l2, b_ + 8192); TRRD(h2, b_ + 10240); TRRD(l3, b_ + 12288); TRRD(h3, b_ + 14336); \
        asm volatile("s_waitcnt lgkmcnt(0)" ::: "memory"); SBAR();                                                                                     \
        o[d0] = __builtin_amdgcn_mfma_f32_32x32x16_bf16(pa0, (bf16x8){l0[0], l0[1], l0[2], l0[3], h0[0], h0[1], h0[2], h0[3]}, o[d0], 0, 0, 0);   \
        o[d0] = __builtin_amdgcn_mfma_f32_32x32x16_bf16(pa1, (bf16x8){l1[0], l1[1], l1[2], l1[3], h1[0], h1[1], h1[2], h1[3]}, o[d0], 0, 0, 0);   \
        o[d0] = __builtin_amdgcn_mfma_f32_32x32x16_bf16(pa2, (bf16x8){l2[0], l2[1], l2[2], l2[3], h2[0], h2[1], h2[2], h2[3]}, o[d0], 0, 0, 0);   \
        o[d0] = __builtin_amdgcn_mfma_f32_32x32x16_bf16(pa3, (bf16x8){l3[0], l3[1], l3[2], l3[3], h3[0], h3[1], h3[2], h3[3]}, o[d0], 0, 0, 0); } while (0)
    PV_D0(0); PV_D0(1); PV_D0(2); PV_D0(3);
#undef PV_D0
#undef TRRD
}
template <class TIn, class TOut>
__device__ __forceinline__ void a2_prime(const BlockRef<TIn, TOut>& cur, int W, char* lds, a2_lchar* ldsl, Seam2& S) {
    A2_LANE_CONSTS();
    S.par = 0; S.g = 0; fill_bias((float*)(lds + A2_BT), cur.RB, cur.dil);
    const int kb0 = swa_jlo(cur.P0, W) * KVBLK;
    A2_GLDS(cur.K, cur.V, cur.RS, kb0, 0); A2_GLDS(cur.K, cur.V, cur.RS, kb0 + KVBLK, 1);
#pragma unroll
    for (int d0 = 0; d0 < 8; ++d0) S.qr[d0] = load8<TIn>(cur.Q + (size_t)(wid * QBLK + r32) * cur.RS + d0 * 16 + hi * 8);
    A2_VMW();
#pragma unroll
    for (int d0 = 0; d0 < 8; ++d0) asm volatile("" : "+v"(S.qr[d0]));
}
template <class TIn, class TOut>
__device__ __forceinline__ void a2_block(const BlockRef<TIn, TOut>& cur, const BlockRef<TIn, TOut>& nxt, int W, char* lds, a2_lchar* ldsl, Seam2& S) {
    A2_LANE_CONSTS();
    constexpr bool SK = true;
    const int j_lo = swa_jlo(cur.P0, W), NT = (cur.P0 + QB - 1) / KVBLK + 1 - j_lo;
    const int kbn = swa_jlo(nxt.P0, W) * KVBLK, g = S.g;
    const int qlo = cur.P0 + wid * QBLK, qm = qlo + r32 - 4 * hi;
    const char* K_lds = lds + A2_K; const int vb0 = (int)(uintptr_t)(lds + A2_V) + v_rd_base(lane);
    float* ws = (float*)(lds + A2_WS) + wid * 64; float* li_l = ws, * al_l = ws + 32;
    const float* bt = (const float*)(lds + A2_BT) + S.par * BT_N;
    float m_reg = -1e30f, l_reg = 0; f32x16 o[4] = {};
#define RESC(a) do { if (__any((a) < 1.f)) { if (hi == 0) al_l[r32] = (a); asm volatile("s_waitcnt lgkmcnt(0)" ::: "memory");              \
                     for (int d_ = 0; d_ < 4; ++d_) for (int r = 0; r < 16; ++r) o[d_][r] *= al_l[crow(r, hi)]; } } while (0)
#define KBASE(t) ((j_lo + (t)) * KVBLK)
#define SLOT(t) (((g + (t)) & 3) * SHM_K)
#define ACT(t) (KBASE(t) <= qlo + QBLK - 1 && KBASE(t) + KVBLK - 1 >= qlo - W + 1)
#define MASKT(P0_, P1_, t) do { if (ACT(t)) mask_tile(P0_, P1_, qm - KBASE(t), (unsigned)W, bt); } while (0)
    f32x16 pA0, pA1, pB0, pB1; float mnA, mnB, alA, alB; bf16x8 pa0, pa1, pa2, pa3;
    A2_BAR();
    A2_GLDS(cur.K, cur.V, cur.RS, KBASE(2), (g + 2) & 3);
    SBAR(); qkt2<SK>(pA0, pA1, K_lds + SLOT(0), r32, hi, S.qr, ACT(0));
    MASKT(pA0, pA1, 0); partialSM(pA0, pA1, m_reg, mnA, alA);
#define STEP(PX0, PX1, mnX, alX, PY0, PY1, alY, t) do {                                                                                       \
        if ((t) + 2 < NT) A2_GLDS(cur.K, cur.V, cur.RS, KBASE((t) + 2), (g + (t) + 2) & 3);                                                   \
        SBAR(); qkt2<SK>(PX0, PX1, K_lds + SLOT(t), r32, hi, S.qr, ACT(t));                                                                   \
        finishSM(PY0, PY1, alY, l_reg, pa0, pa1, pa2, pa3); SBAR();                                                                           \
        pv2<SK>(o, vb0 + SLOT((t) - 1), pa0, pa1, pa2, pa3, ACT((t) - 1)); MASKT(PX0, PX1, (t)); partialSM(PX0, PX1, m_reg, mnX, alX);       \
        RESC(alX);                                                                                                                            \
        if ((t) + 2 < NT) A2_VMWN(4); else A2_VMW();                                \
        A2_BAR(); } while (0)
    for (int t = 1; t + 1 < NT - 1; t += 2) {
        STEP(pB0, pB1, mnB, alB, pA0, pA1, alA, t);
        STEP(pA0, pA1, mnA, alA, pB0, pB1, alB, t + 1);
    }
    const bool newtab = (nxt.RB != cur.RB) || (nxt.dil != cur.dil);
    if (newtab) fill_bias((float*)(lds + A2_BT) + (S.par ^ 1) * BT_N, nxt.RB, nxt.dil);
    A2_GLDS(nxt.K, nxt.V, nxt.RS, kbn, (g + NT) & 3); A2_GLDS(nxt.K, nxt.V, nxt.RS, kbn + KVBLK, (g + NT + 1) & 3);
    SBAR(); qkt2<SK>(pB0, pB1, K_lds + SLOT(NT - 1), r32, hi, S.qr, ACT(NT - 1)); SBAR();
#pragma unroll
    for (int d0 = 0; d0 < 8; ++d0) S.qr[d0] = load8<TIn>(nxt.Q + (size_t)(wid * QBLK + r32) * nxt.RS + d0 * 16 + hi * 8);
    SBAR();
    finishSM(pA0, pA1, alA, l_reg, pa0, pa1, pa2, pa3); SBAR();
    pv2<SK>(o, vb0 + SLOT(NT - 2), pa0, pa1, pa2, pa3, ACT(NT - 2));
    MASKT(pB0, pB1, NT - 1); partialSM(pB0, pB1, m_reg, mnB, alB); RESC(alB);
    finishSM(pB0, pB1, alB, l_reg, pa0, pa1, pa2, pa3); SBAR();
    pv2<SK>(o, vb0 + SLOT(NT - 1), pa0, pa1, pa2, pa3, ACT(NT - 1));
    A2_VMW();
#pragma unroll
    for (int d0 = 0; d0 < 8; ++d0) asm volatile("" : "+v"(S.qr[d0]));
    if (hi == 0) { li_l[r32] = l_reg; cur.LSE[(size_t)(wid * QBLK + r32) * (size_t)(16 * cur.dil)] = m_reg * SCALE + __logf(l_reg); }
    asm volatile("s_waitcnt lgkmcnt(0)" ::: "memory");
    float rli[16];
#pragma unroll
    for (int r = 0; r < 16; ++r) rli[r] = __builtin_amdgcn_rcpf(li_l[crow(r, hi)]);
    if (!(cur.flags & 1)) {
        char* st = lds + A2_OST + wid * 2560; char* stw = st + (4 * hi) * 80 + r32 * 2;
        TOut* Og = cur.O + (size_t)(wid * QBLK) * cur.RS;
#pragma unroll
        for (int d0 = 0; d0 < 4; ++d0) {
#pragma unroll
            for (int r = 0; r < 16; ++r) { const float v = o[d0][r] * rli[r]; const float vn = __shfl_xor(v, 1);
                if ((r32 & 1) == 0) *(unsigned*)(stw + ((r & 3) + 8 * (r >> 2)) * 80) = cvtpk(v, vn); }
            asm volatile("s_waitcnt lgkmcnt(0)" ::: "memory");
            u32x4 w0 = *(const u32x4*)(st + (lane >> 2) * 80 + (lane & 3) * 16), w1 = *(const u32x4*)(st + (16 + (lane >> 2)) * 80 + (lane & 3) * 16);
            asm volatile("s_waitcnt lgkmcnt(0)" ::: "memory");
            *(u32x4*)(Og + (size_t)(lane >> 2) * cur.RS + d0 * 32 + (lane & 3) * 8) = w0;
            *(u32x4*)(Og + (size_t)(16 + (lane >> 2)) * cur.RS + d0 * 32 + (lane & 3) * 8) = w1; }
    }
    if (newtab) S.par ^= 1;
    S.g = (g + NT) & 3;
#undef RESC
#undef KBASE
#undef SLOT
#undef ACT
#undef MASKT
#undef STEP
}
}
typedef unsigned short bf16_t;
typedef short bf16x8 __attribute__((ext_vector_type(8)));
typedef float f32x4 __attribute__((ext_vector_type(4)));
typedef float f32x2 __attribute__((ext_vector_type(2)));
typedef unsigned u32x4 __attribute__((ext_vector_type(4)));
typedef unsigned u32x2 __attribute__((ext_vector_type(2)));
__device__ __forceinline__ unsigned cvtpk2(float lo, float hi) { unsigned r; asm volatile("v_cvt_pk_bf16_f32 %0, %1, %2" : "=v"(r) : "v"(lo), "v"(hi)); return r; }
__device__ __forceinline__ float bf_lo(unsigned w) { return __uint_as_float(w << 16); }
__device__ __forceinline__ float bf_hi(unsigned w) { return __uint_as_float(w & 0xffff0000u); }
__device__ __forceinline__ float wave_sum(float v) {
#pragma unroll
    for (int o = 32; o >= 1; o >>= 1) v += __shfl_xor(v, o);
    return v;
}

__device__ __forceinline__ void p0_rmsnorm_x(const float* __restrict__ x, const float* __restrict__ g, bf16_t* __restrict__ hn, int G) {
    const int lane = tidx() & 63, wid = tidx() >> 6;
    for (int row = blockIdx.x * 8 + wid; row < M_TOK; row += G * 8) {
        const float* xr = x + (size_t)row * DM; f32x4 v[16]; float s = 0.f;
#pragma unroll
        for (int j = 0; j < 8; ++j) { v[2 * j] = *(const f32x4*)(xr + (j * 64 + lane) * 8); v[2 * j + 1] = *(const f32x4*)(xr + (j * 64 + lane) * 8 + 4); }
#pragma unroll
        for (int j = 0; j < 16; ++j) s += (v[j][0] * v[j][0] + v[j][1] * v[j][1]) + (v[j][2] * v[j][2] + v[j][3] * v[j][3]);
        s = wave_sum(s);
        const float rs = __builtin_amdgcn_rsqf(s * (1.0f / DM) + EPS);
#pragma unroll
        for (int j = 0; j < 8; ++j) { const int c = (j * 64 + lane) * 8; const f32x4 g0 = *(const f32x4*)(g + c), g1 = *(const f32x4*)(g + c + 4);
            const f32x4 a = v[2 * j] * rs * g0, b = v[2 * j + 1] * rs * g1;
            u32x4 w; w.x = cvtpk2(a[0], a[1]); w.y = cvtpk2(a[2], a[3]); w.z = cvtpk2(b[0], b[1]); w.w = cvtpk2(b[2], b[3]);
            *(u32x4*)(hn + (size_t)row * DM + c) = w; }
    }
}
__device__ __forceinline__ void p0_transpose_item(const float* __restrict__ W, const float* __restrict__ sc, int K, int N, bf16_t* __restrict__ WT, LAS float* scr, int item, int lane) {
    const int nblk = N / 32, kb = item / nblk, nb = item % nblk, k0 = 64 * kb, n0 = 32 * nb;
    f32x4 r[8];
#pragma unroll
    for (int i = 0; i < 8; ++i) r[i] = *(const f32x4*)(W + (size_t)(k0 + 8 * i + (lane >> 3)) * N + n0 + 4 * (lane & 7));
    if (sc) {
#pragma unroll
        for (int i = 0; i < 8; ++i) r[i] = r[i] * sc[k0 + 8 * i + (lane >> 3)]; }
#pragma unroll
    for (int i = 0; i < 8; ++i) { LAS float* d = scr + (8 * i + (lane >> 3)) * 33 + 4 * (lane & 7); d[0] = r[i][0]; d[1] = r[i][1]; d[2] = r[i][2]; d[3] = r[i][3]; }
    asm volatile("s_waitcnt lgkmcnt(0)" ::: "memory");
    const int c = lane & 7;
#pragma unroll
    for (int j = 0; j < 4; ++j) { const int n = (lane >> 3) + 8 * j; const LAS float* t = scr + (8 * c) * 33 + n;
        u32x4 o; o.x = cvtpk2(t[0 * 33], t[1 * 33]); o.y = cvtpk2(t[2 * 33], t[3 * 33]); o.z = cvtpk2(t[4 * 33], t[5 * 33]); o.w = cvtpk2(t[6 * 33], t[7 * 33]);
        *(u32x4*)(WT + (size_t)(n0 + n) * K + k0 + 8 * c) = o; }
    asm volatile("s_waitcnt lgkmcnt(0)" ::: "memory");
}
__device__ __forceinline__ void p0_weights(const float* w_in, const float* w_out, const float* w_gate, const float* g_ple, const float* w_up,
                                           bf16_t* WIN, bf16_t* WOUT, bf16_t* WG, bf16_t* WUP, int G, LAS unsigned char* lds) {
    const int tid = tidx(), lane = tid & 63, wave = tid >> 6;
    LAS float* scr = (LAS float*)(lds + wave * 16384);
    constexpr int I_IN = (DM / 64) * (DIN / 32), I_SQ = (DM / 64) * (DM / 32), I_UP = (DPLE / 64) * (DM / 32), NITEMS = I_IN + 2 * I_SQ + I_UP;
    for (int it = (int)blockIdx.x * 8 + wave; it < NITEMS; it += G * 8) {
        int r = it;
        if (r < I_IN) { p0_transpose_item(w_in, nullptr, DM, DIN, WIN, scr, r, lane); continue; } r -= I_IN;
        if (r < I_SQ) { p0_transpose_item(w_out, nullptr, DM, DM, WOUT, scr, r, lane); continue; } r -= I_SQ;
        if (r < I_SQ) { p0_transpose_item(w_gate, g_ple, DM, DM, WG, scr, r, lane); continue; } r -= I_SQ;
        p0_transpose_item(w_up, nullptr, DPLE, DM, WUP, scr, r, lane);
    }
    __syncthreads();
}
__device__ __forceinline__ void p0_convert_p(const float* __restrict__ p, bf16_t* __restrict__ pb, int G) {
    const size_t n8 = (size_t)M_TOK * DPLE / 8;
    for (size_t i = (size_t)blockIdx.x * 512 + tidx(); i < n8; i += (size_t)G * 512) { const f32x4 a = *(const f32x4*)(p + i * 8), b = *(const f32x4*)(p + i * 8 + 4);
        u32x4 w; w.x = cvtpk2(a[0], a[1]); w.y = cvtpk2(a[2], a[3]); w.z = cvtpk2(b[0], b[1]); w.w = cvtpk2(b[2], b[3]); *(u32x4*)(pb + i * 8) = w; }
}

constexpr int VT_STRIDE = 136;
__device__ __forceinline__ void p2_gmlp(bf16_t* __restrict__ AU, const bf16_t* __restrict__ AV, const float* __restrict__ lnp, const float* __restrict__ lng, const float* __restrict__ lnb,
                                         const float* __restrict__ ws, const float* __restrict__ bs, int G, LAS unsigned char* lds) {
    const int tid = tidx(), lane = tid & 63, wid = tid >> 6, fr = lane & 15, fq = lane >> 4;
    LAS float* ST = (LAS float*)(lds + 2 * 128 * VT_STRIDE * 2);
    for (int item = blockIdx.x; item < 256; item += G) {
        const int cn = item >> 1, g0 = (item & 1) * 8, T0 = cn * 128;
        u32x4 av[4];
#pragma unroll
        for (int it = 0; it < 4; ++it) { const int idx = it * 512 + tid, s = idx >> 4, ch = (idx & 15) * 8; av[it] = *(const u32x4*)(AV + (size_t)(T0 + s) * WBR + g0 * 128 + ch); }
        __syncthreads();
        if (tid < 128) { const float* pp = lnp + (size_t)(T0 + tid) * 64; float s1 = 0.f, s2 = 0.f;
#pragma unroll
            for (int i = 0; i < 16; ++i) { const f32x4 q = *(const f32x4*)(pp + 4 * i); s1 += q[0] + q[2]; s2 += q[1] + q[3]; }
            const float mean = s1 * (1.0f / WBR), var = s2 * (1.0f / WBR) - mean * mean;
            ST[2 * tid] = mean; ST[2 * tid + 1] = __builtin_amdgcn_rsqf(fmaxf(var, 0.f) + EPS); }
        __syncthreads();
        const int t = 16 * wid + fr, nks = (16 * wid + 15) / 32 + 1;
        for (int gi = 0; gi < 8; ++gi) { const int g = g0 + gi;
            LAS bf16_t* VT = (LAS bf16_t*)(lds + (gi & 1) * (128 * VT_STRIDE * 2));
            const float* wrow = ws + ((size_t)g * 128 + t) * 128; f32x4 w0[4], w1[4];
#pragma unroll
            for (int ks = 0; ks < 4; ++ks) if (ks < nks) { w0[ks] = *(const f32x4*)(wrow + 32 * ks + 8 * fq); w1[ks] = *(const f32x4*)(wrow + 32 * ks + 8 * fq + 4); }
            u32x2 au[8];
#pragma unroll
            for (int n = 0; n < 8; ++n) au[n] = *(const u32x2*)(AU + (size_t)(T0 + t) * WBR + g * 128 + 16 * n + 4 * fq);
            const float bias = bs[g * 128 + t];
#pragma unroll
            for (int it = 0; it < 4; ++it) { const int idx = it * 512 + tid, s = idx >> 4, ch = (idx & 15) * 8; const u32x4 w = av[it];
                const float mean = ST[2 * s], rstd = ST[2 * s + 1];
                const f32x4 g0v = *(const f32x4*)(lng + g * 128 + ch), g1v = *(const f32x4*)(lng + g * 128 + ch + 4), b0v = *(const f32x4*)(lnb + g * 128 + ch), b1v = *(const f32x4*)(lnb + g * 128 + ch + 4);
                float v[8] = {bf_lo(w.x), bf_hi(w.x), bf_lo(w.y), bf_hi(w.y), bf_lo(w.z), bf_hi(w.z), bf_lo(w.w), bf_hi(w.w)};
#pragma unroll
                for (int e = 0; e < 8; ++e) { const float gg = e < 4 ? g0v[e & 3] : g1v[e & 3], bb = e < 4 ? b0v[e & 3] : b1v[e & 3];
                    const float y = (v[e] - mean) * rstd * gg + bb; const unsigned pk = cvtpk2(y, y); VT[(ch + e) * VT_STRIDE + s] = (bf16_t)(pk & 0xffffu); } }
            if (gi < 7) {
#pragma unroll
                for (int it = 0; it < 4; ++it) { const int idx = it * 512 + tid, s = idx >> 4, ch = (idx & 15) * 8; av[it] = *(const u32x4*)(AV + (size_t)(T0 + s) * WBR + (g + 1) * 128 + ch); } }
            __syncthreads();
            f32x4 acc[8];
#pragma unroll
            for (int n = 0; n < 8; ++n) acc[n] = (f32x4){0.f, 0.f, 0.f, 0.f};
#pragma unroll
            for (int ks = 0; ks < 4; ++ks) if (ks < nks) { const int s0 = 32 * ks + 8 * fq;
                float wv[8] = {w0[ks][0], w0[ks][1], w0[ks][2], w0[ks][3], w1[ks][0], w1[ks][1], w1[ks][2], w1[ks][3]};
#pragma unroll
                for (int e = 0; e < 8; ++e) wv[e] = (s0 + e <= t) ? wv[e] : 0.f;
                u32x4 wp; wp.x = cvtpk2(wv[0], wv[1]); wp.y = cvtpk2(wv[2], wv[3]); wp.z = cvtpk2(wv[4], wv[5]); wp.w = cvtpk2(wv[6], wv[7]);
                const bf16x8 wf = *reinterpret_cast<bf16x8*>(&wp);
#pragma unroll
                for (int n = 0; n < 8; ++n) { const bf16x8 vf = *(const LAS bf16x8*)(VT + (16 * n + fr) * VT_STRIDE + s0);
                    acc[n] = __builtin_amdgcn_mfma_f32_16x16x32_bf16(vf, wf, acc[n], 0, 0, 0); } }
#pragma unroll
            for (int n = 0; n < 8; ++n) { const u32x2 a = au[n];
                const pg8::f32x2 u0 = pg8::gelu_pk((pg8::f32x2){bf_lo(a.x), bf_hi(a.x)}), u1 = pg8::gelu_pk((pg8::f32x2){bf_lo(a.y), bf_hi(a.y)});
                u32x2 o; o.x = cvtpk2(u0.x * (acc[n][0] + bias), u0.y * (acc[n][1] + bias)); o.y = cvtpk2(u1.x * (acc[n][2] + bias), u1.y * (acc[n][3] + bias));
                *(u32x2*)(AU + (size_t)(T0 + t) * WBR + g * 128 + 16 * n + 4 * fq) = o; }
        }
    }
    __syncthreads();
}

__device__ __forceinline__ void p3_merge(const bf16_t* __restrict__ proj, const bf16_t* __restrict__ OC, const float* __restrict__ lse, const float* __restrict__ ga, const float* __restrict__ gb,
                                          bf16_t* __restrict__ Y, int G) {
    const int lane = tidx() & 63, wid = tidx() >> 6;
    const bf16_t* YA = proj; const bf16_t* AZ = proj + 2 * SEG; const bf16_t* BZ = proj + 6 * SEG;
    for (int row = blockIdx.x * 8 + wid; row < M_TOK; row += G * 8) {
        float va[4][8], vb[4][8]; float ssa = 0.f, ssb = 0.f;
#pragma unroll
        for (int j = 0; j < 4; ++j) { const int c = 8 * (lane + 64 * j); const size_t o = (size_t)row * WBR + c;
            const u32x4 w = *(const u32x4*)(YA + o);
            va[j][0] = bf_lo(w.x); va[j][1] = bf_hi(w.x); va[j][2] = bf_lo(w.y); va[j][3] = bf_hi(w.y); va[j][4] = bf_lo(w.z); va[j][5] = bf_hi(w.z); va[j][6] = bf_lo(w.w); va[j][7] = bf_hi(w.w);
#pragma unroll
            for (int e = 0; e < 8; ++e) ssa += va[j][e] * va[j][e];
            const int h = c >> 7; const float l0 = lse[(size_t)row * 16 + h], l1 = lse[(size_t)(M_TOK + row) * 16 + h], l2 = lse[(size_t)(2 * M_TOK + row) * 16 + h];
            const float mx = fmaxf(l0, fmaxf(l1, l2)); const float e0 = __expf(l0 - mx), e1 = __expf(l1 - mx), e2 = __expf(l2 - mx); const float inv = 1.0f / (e0 + e1 + e2);
            const float a0 = e0 * inv, a1 = e1 * inv, a2 = e2 * inv;
            const u32x4 o0 = *(const u32x4*)(OC + o), o1 = *(const u32x4*)(OC + SEG + o), o2 = *(const u32x4*)(OC + 2 * SEG + o);
            vb[j][0] = a0 * bf_lo(o0.x) + a1 * bf_lo(o1.x) + a2 * bf_lo(o2.x); vb[j][1] = a0 * bf_hi(o0.x) + a1 * bf_hi(o1.x) + a2 * bf_hi(o2.x);
            vb[j][2] = a0 * bf_lo(o0.y) + a1 * bf_lo(o1.y) + a2 * bf_lo(o2.y); vb[j][3] = a0 * bf_hi(o0.y) + a1 * bf_hi(o1.y) + a2 * bf_hi(o2.y);
            vb[j][4] = a0 * bf_lo(o0.z) + a1 * bf_lo(o1.z) + a2 * bf_lo(o2.z); vb[j][5] = a0 * bf_hi(o0.z) + a1 * bf_hi(o1.z) + a2 * bf_hi(o2.z);
            vb[j][6] = a0 * bf_lo(o0.w) + a1 * bf_lo(o1.w) + a2 * bf_lo(o2.w); vb[j][7] = a0 * bf_hi(o0.w) + a1 * bf_hi(o1.w) + a2 * bf_hi(o2.w);
#pragma unroll
            for (int e = 0; e < 8; ++e) ssb += vb[j][e] * vb[j][e]; }
        ssa = wave_sum(ssa); ssb = wave_sum(ssb);
        const float rsa = __builtin_amdgcn_rsqf(ssa * (1.0f / WBR) + EPS), rsb = __builtin_amdgcn_rsqf(ssb * (1.0f / WBR) + EPS);
#pragma unroll
        for (int j = 0; j < 4; ++j) { const int c = 8 * (lane + 64 * j); const size_t o = (size_t)row * WBR + c;
            const u32x4 zar = *(const u32x4*)(AZ + o), zbr = *(const u32x4*)(BZ + o);
            float sa[8] = {bf_lo(zar.x), bf_hi(zar.x), bf_lo(zar.y), bf_hi(zar.y), bf_lo(zar.z), bf_hi(zar.z), bf_lo(zar.w), bf_hi(zar.w)};
            float sb[8] = {bf_lo(zbr.x), bf_hi(zbr.x), bf_lo(zbr.y), bf_hi(zbr.y), bf_lo(zbr.z), bf_hi(zbr.z), bf_lo(zbr.w), bf_hi(zbr.w)};
#pragma unroll
            for (int e = 0; e < 8; ++e) { sa[e] = sa[e] * pg8::sigmoidf_(sa[e]); sb[e] = sb[e] * pg8::sigmoidf_(sb[e]); }
            const f32x4 ga0 = *(const f32x4*)(ga + c), ga1 = *(const f32x4*)(ga + c + 4), gb0 = *(const f32x4*)(gb + c), gb1 = *(const f32x4*)(gb + c + 4);
            u32x4 wa, wb;
            wa.x = cvtpk2(va[j][0] * rsa * ga0[0] * sa[0], va[j][1] * rsa * ga0[1] * sa[1]); wa.y = cvtpk2(va[j][2] * rsa * ga0[2] * sa[2], va[j][3] * rsa * ga0[3] * sa[3]);
            wa.z = cvtpk2(va[j][4] * rsa * ga1[0] * sa[4], va[j][5] * rsa * ga1[1] * sa[5]); wa.w = cvtpk2(va[j][6] * rsa * ga1[2] * sa[6], va[j][7] * rsa * ga1[3] * sa[7]);
            wb.x = cvtpk2(vb[j][0] * rsb * gb0[0] * sb[0], vb[j][1] * rsb * gb0[1] * sb[1]); wb.y = cvtpk2(vb[j][2] * rsb * gb0[2] * sb[2], vb[j][3] * rsb * gb0[3] * sb[3]);
            wb.z = cvtpk2(vb[j][4] * rsb * gb1[0] * sb[4], vb[j][5] * rsb * gb1[1] * sb[5]); wb.w = cvtpk2(vb[j][6] * rsb * gb1[2] * sb[6], vb[j][7] * rsb * gb1[3] * sb[7]);
            *(u32x4*)(Y + (size_t)row * DM + c) = wa; *(u32x4*)(Y + (size_t)row * DM + WBR + c) = wb; }
    }
}
#ifndef PROBE_REP
#define PROBE_REP 0
#endif
#ifndef PROBE_IDLE_US
#define PROBE_IDLE_US 0
#endif
#ifndef PROBE_ATT_NOSTORE
#define PROBE_ATT_NOSTORE 0
#endif
#ifndef PROBE_NULLEPI
#define PROBE_NULLEPI 0
#endif
#define REPS(k) (((PROBE_REP >> (k)) & 1) ? 2 : 1)
__device__ __forceinline__ att::BlockRef<__hip_bfloat16, __hip_bfloat16> att_ref(int id, const bf16_t* proj, bf16_t* OC, float* lse, const float* relb) {
    id = id % 3072; const int cfg = id >> 10, rem = id & 1023, bh = rem >> 4, within = rem & 15, b = bh >> 4, h = bh & 15;
    const int dil = cfg == 0 ? 1 : (cfg == 1 ? 4 : 16), nqb = 16 / dil, r = within / nqb, qb = within % nqb;
    const size_t tok0 = (size_t)b * SEQ + r, tokq = tok0 + (size_t)(qb * 256) * dil;
    att::BlockRef<__hip_bfloat16, __hip_bfloat16> R;
    R.Q = (const __hip_bfloat16*)(proj + 3 * SEG + tokq * WBR + h * 128);
    R.K = (const __hip_bfloat16*)(proj + 4 * SEG + tok0 * WBR + h * 128);
    R.V = (const __hip_bfloat16*)(proj + 5 * SEG + tok0 * WBR + h * 128);
    R.O = (__hip_bfloat16*)(OC + (size_t)cfg * SEG + tokq * WBR + h * 128);
    R.LSE = lse + ((size_t)cfg * M_TOK + tokq) * 16 + h; R.RB = relb + h; R.P0 = qb * 256; R.RS = dil * WBR; R.dil = dil; R.flags = 0;
    return R;
}
__device__ __forceinline__ void p2_attention(const bf16_t* proj, bf16_t* OC, float* lse, const float* relb, int G, char* lds) {
    constexpr int NIT = 1024; typedef att::BlockRef<__hip_bfloat16, __hip_bfloat16> BR;
    const bool even = (NIT % G) == 0; const int run = even ? NIT / G : 0, nmine = even ? 3 * run * REPS(2) : (3 * NIT - (int)blockIdx.x + G - 1) / G;
    if (nmine <= 0) return;
#define ATT_ID(k_) (even ? ((((k_) / run) % 3) * NIT + (int)blockIdx.x * run + (k_) % run) : ((int)blockIdx.x + (k_) * G))
    int k = 0; BR cur = att_ref(ATT_ID(0), proj, OC, lse, relb);
    att::a2_lchar* ldsl = (att::a2_lchar*)lds_raw;
    att::Seam2 S;
    if (__builtin_amdgcn_readfirstlane(tidx() >> 6) >= 4) __builtin_amdgcn_s_setprio(1);
    att::a2_prime<__hip_bfloat16, __hip_bfloat16>(cur, 129, lds, ldsl, S);
    for (;;) {
        const bool last = k + 1 >= nmine;
        BR nxt = last ? cur : att_ref(ATT_ID(k + 1), proj, OC, lse, relb);
#if PROBE_ATT_NOSTORE
        if (k + 1 >= 3 * run) nxt.flags = 1;
#endif
        att::a2_block<__hip_bfloat16, __hip_bfloat16>(cur, nxt, 129, lds, ldsl, S);
        if (last) break;
        cur = nxt; ++k;
    }
    __builtin_amdgcn_s_setprio(0);
    asm volatile("s_waitcnt vmcnt(0) lgkmcnt(0)" ::: "memory"); __syncthreads();
#undef ATT_ID
}

#define XB_TMO      128
#define XB_XCNT(j)  (256  + 64 * (j))
#define XB_XSUB(j)  (1280 + 64 * (j))
#define XB_XGEN(j)  (2304 + 64 * (j))
#define XB_TOP      3328
#define XB_TOPGEN   3392
#define XCD_BAR_WORDS 3456
#define XB_SPIN_CAP (1u << 18)

__device__ __forceinline__ unsigned xb_ld(unsigned* p)              { return __hip_atomic_load(p, __ATOMIC_RELAXED, __HIP_MEMORY_SCOPE_AGENT); }
__device__ __forceinline__ unsigned xb_add(unsigned* p, unsigned v) { return __hip_atomic_fetch_add(p, v, __ATOMIC_RELAXED, __HIP_MEMORY_SCOPE_AGENT); }
__device__ __forceinline__ unsigned xb_xcc_id() { return (unsigned)__builtin_amdgcn_s_getreg((3 << 11) | 20) & 0xFu; }
#define XB_SPIN(cond, bar) do { unsigned _sp = 0; while (cond) { __builtin_amdgcn_s_sleep(1); \
    if ((++_sp & 255u) == 0u) { if (xb_ld(&(bar)[XB_TMO])) break; if (_sp > XB_SPIN_CAP) { atomicAdd(&(bar)[XB_TMO], 1u); break; } } } } while (0)

struct XcdBarrier {
    unsigned* bar; unsigned x;
    volatile LAS unsigned* st;
};

__device__ __forceinline__ XcdBarrier xcd_barrier_post(unsigned* bar, volatile LAS unsigned* st) {
    XcdBarrier b; b.bar = bar; b.x = xb_xcc_id(); b.st = st;
    if (tidx() == 0) (void)xb_add(&bar[XB_XCNT(b.x)], 1u);
    return b;
}
__device__ __forceinline__ void xcd_barrier_complete(unsigned* bar, unsigned x, unsigned& nloc, unsigned& nx) {
    const unsigned G = gridDim.x * gridDim.y * gridDim.z;
    unsigned sum, cnt, mine, sp = 0u;
    for (;;) {
        sum = 0u; cnt = 0u; mine = 0u;
#pragma unroll
        for (unsigned j = 0; j < 16; ++j) { const unsigned c = xb_ld(&bar[XB_XCNT(j)]); sum += c; cnt += (c > 0u) ? 1u : 0u; mine = (j == x) ? c : mine; }
        if (sum == G) break;
        __builtin_amdgcn_s_sleep(1);
        if ((++sp & 255u) == 0u) { if (xb_ld(&bar[XB_TMO])) break; if (sp > XB_SPIN_CAP) { atomicAdd(&bar[XB_TMO], 1u); break; } }
    }
    nloc = mine > 0u ? mine : 1u; nx = cnt > 0u ? cnt : 1u;
}

__device__ __forceinline__ void xcd_barrier(const XcdBarrier& b) {
    asm volatile("s_waitcnt vmcnt(0)" ::: "memory");
    __syncthreads();
    if (tidx() == 0) {
        unsigned* bar = b.bar;
        __builtin_amdgcn_s_waitcnt(0);
        unsigned nloc = b.st[0], nx = b.st[1];
        if (nloc == 0u) { xcd_barrier_complete(bar, b.x, nloc, nx); b.st[0] = nloc; b.st[1] = nx; }
        const unsigned old = xb_add(&bar[XB_XSUB(b.x)], 1u);
        const unsigned gen = old / nloc;
        if (old + 1u == (gen + 1u) * nloc) {
            __builtin_amdgcn_fence(__ATOMIC_RELEASE, "agent");
            asm volatile("s_waitcnt vmcnt(0)" ::: "memory");
            const unsigned og = xb_add(&bar[XB_TOP], 1u);
            const unsigned tg = og / nx;
            if (og + 1u == (tg + 1u) * nx) xb_add(&bar[XB_TOPGEN], 1u);
            else XB_SPIN(xb_ld(&bar[XB_TOPGEN]) == tg, bar);
            __builtin_amdgcn_fence(__ATOMIC_ACQUIRE, "agent");
            xb_add(&bar[XB_XGEN(b.x)], 1u);
            asm volatile("s_waitcnt vmcnt(0)" ::: "memory");
        } else {
            XB_SPIN(xb_ld(&bar[XB_XGEN(b.x)]) == gen, bar);
            __builtin_amdgcn_fence(__ATOMIC_ACQUIRE, "agent");
            asm volatile("s_waitcnt vmcnt(0)" ::: "memory");
        }
    }
    __syncthreads();
}
__device__ __forceinline__ void grid_barrier(unsigned* ctr, unsigned target) {
    asm volatile("s_waitcnt vmcnt(0) lgkmcnt(0)" ::: "memory");
    __syncthreads();
    if (tidx() == 0) {
        __builtin_amdgcn_fence(__ATOMIC_RELEASE, "agent");
        asm volatile("s_waitcnt vmcnt(0)" ::: "memory");
        __hip_atomic_fetch_add(ctr, 1u, __ATOMIC_RELAXED, __HIP_MEMORY_SCOPE_AGENT);
        while (__hip_atomic_load(ctr, __ATOMIC_RELAXED, __HIP_MEMORY_SCOPE_AGENT) < target) __builtin_amdgcn_s_sleep(2);
        __builtin_amdgcn_fence(__ATOMIC_ACQUIRE, "agent");
        asm volatile("s_waitcnt vmcnt(0)" ::: "memory");
    }
    __syncthreads();
}
struct Params { const float* in[17]; float* out; unsigned char* ws; int ph_lo, ph_hi; };
constexpr int NPHASE = 6;
__global__ void __launch_bounds__(512, 2) hybrid_layer_fwd(Params P) {
    LAS unsigned char* lds = (LAS unsigned char*)lds_raw;
    { const int t0 = (int)__builtin_amdgcn_workitem_id_x(); if ((t0 & 63) == 0) ((LAS int*)(lds + LDS_WTAB))[hw_slot()] = t0 >> 6; __syncthreads(); }
    cg::grid_group grid = cg::this_grid();
    const int G = gridDim.x, lo = P.ph_lo, hi = P.ph_hi;
    unsigned char* ws = P.ws;
    const float* x = P.in[0]; const float* p = P.in[1]; const float* g_pre = P.in[2]; const float* w_in = P.in[3]; const float* w_s = P.in[4]; const float* b_s = P.in[5];
    const float* ln_v_g = P.in[6]; const float* ln_v_b = P.in[7]; const float* g_q = P.in[8]; const float* g_k = P.in[9]; const float* rel_bias = P.in[10];
    const float* g_out_a = P.in[11]; const float* g_out_b = P.in[12]; const float* w_out = P.in[13]; const float* g_ple = P.in[14]; const float* w_gate = P.in[15]; const float* w_up = P.in[16];
    bf16_t* HN = (bf16_t*)(ws + WS_HN); bf16_t* WIN = (bf16_t*)(ws + WS_WIN); bf16_t* WOUT = (bf16_t*)(ws + WS_WOUT); bf16_t* WG = (bf16_t*)(ws + WS_WG); bf16_t* WUP = (bf16_t*)(ws + WS_WUP);
    bf16_t* PB = (bf16_t*)(ws + WS_PB); float* LNP = (float*)(ws + WS_LNP); float* HSQ = (float*)(ws + WS_HSQ); float* LSE = (float*)(ws + WS_LSE);
    bf16_t* PROJ = (bf16_t*)(ws + WS_PROJ); bf16_t* OC = (bf16_t*)(ws + WS_OC); bf16_t* HB = (bf16_t*)(ws + WS_HB); bf16_t* UB = (bf16_t*)(ws + WS_UB);
#define IN_PH(k) (lo <= (k) && (k) < hi)
    unsigned* CTL = (unsigned*)(ws + WS_CTL);
    XcdBarrier xbar; xbar.bar = CTL + 1024; xbar.x = 0; xbar.st = (volatile LAS unsigned*)(lds + LDS_XB);
    if (lo == 0 && hi == NPHASE) { if (tidx() < 2) ((LAS unsigned*)(lds + LDS_XB))[tidx()] = 0u; __syncthreads(); xbar = xcd_barrier_post(CTL + 1024, (volatile LAS unsigned*)(lds + LDS_XB)); }
    if (lo < 0) grid.sync();
#define SEAM(k) do { if (lo <= (k) && (k) + 1 < hi) xcd_barrier(xbar); } while (0)

    if (IN_PH(0)) for (int rep_ = 0; rep_ < REPS(0); ++rep_) {
        p0_rmsnorm_x(x, g_pre, HN, G);
        p0_convert_p(p, PB, G);
        p0_weights(w_in, w_out, w_gate, g_ple, w_up, WIN, WOUT, WG, WUP, G, lds);
    }
    SEAM(0);
    if (IN_PH(1)) for (int rep_ = 0; rep_ < REPS(1); ++rep_) {
        pg8::Gemm g{HN, WIN, M_TOK, DIN, DM}; pg8::StaticOrder S; S.init(M_TOK, DIN, G, (int)blockIdx.x);
        pg8::EpiProj E{PROJ, LNP, g_q, g_k, (LAS float*)(lds + LDS_X)};
        pg8::gemm_phase<pg8::EpiProj, pg8::StaticOrder>(lds, g, S, E, nullptr);
#if PROBE_NULLEPI == 1
        { pg8::EpiNull E0{LNP}; pg8::gemm_phase<pg8::EpiNull, pg8::StaticOrder>(lds, g, S, E0, nullptr); }
#endif
    }
    SEAM(1);
#if PROBE_IDLE_US
    { const unsigned long long t0_ = __builtin_amdgcn_s_memrealtime();
      while (__builtin_amdgcn_s_memrealtime() - t0_ < (unsigned long long)(PROBE_IDLE_US * 100)) __builtin_amdgcn_s_sleep(64); }
#endif
    if (IN_PH(2)) {
        p2_attention(PROJ, OC, LSE, rel_bias, G, (char*)lds_raw);
        p2_gmlp(PROJ, PROJ + SEG, LNP, ln_v_g, ln_v_b, w_s, b_s, G, lds);
    }
    SEAM(2);
    if (IN_PH(3)) for (int rep_ = 0; rep_ < REPS(3); ++rep_) p3_merge(PROJ, OC, LSE, g_out_a, g_out_b, HN, G);
    SEAM(3);
    if (IN_PH(4)) for (int rep_ = 0; rep_ < REPS(4); ++rep_) {
        { pg8::Gemm g{PB, WUP, M_TOK, DM, DPLE}; pg8::StaticOrder S; S.init(M_TOK, DM, G, (int)blockIdx.x);
          pg8::EpiU E{UB};
          for (int r2_ = 0; r2_ < REPS(6); ++r2_) pg8::gemm_phase<pg8::EpiU, pg8::StaticOrder>(lds, g, S, E, nullptr); }
        { pg8::Gemm g{HN, WOUT, M_TOK, DM, DM}; pg8::StaticOrder S; S.init(M_TOK, DM, G, (int)blockIdx.x);
          pg8::EpiH E{x, HB, HSQ};
          pg8::gemm_phase<pg8::EpiH, pg8::StaticOrder>(lds, g, S, E, nullptr); }
    }
    SEAM(4);
    if (IN_PH(5)) for (int rep_ = 0; rep_ < REPS(5); ++rep_) {
        pg8::Gemm g{HB, WG, M_TOK, DM, DM}; pg8::RsOrder S; S.init(M_TOK, DM, G, (int)blockIdx.x); S.hsq = HSQ; S.RS = (LAS float*)(lds + LDS_RS); S.selm = (G == 256) ? 0 : 1;
        pg8::EpiOut E{HB, UB, P.out, (LAS float*)(lds + LDS_RS), (G == 256) ? 0 : 1};
        pg8::gemm_phase<pg8::EpiOut, pg8::RsOrder>(lds, g, S, E, nullptr);
    }
#undef IN_PH
#undef SEAM
}

#ifndef MK_LAUNCHES
#define MK_LAUNCHES 1
#endif
extern "C" void kernel_launch(void* const* d_in, const int* in_sizes, int n_in, void* d_out, int out_size, void* d_ws, size_t ws_size, hipStream_t stream) {
    static int grid = 0;
    if (grid == 0) {
        if (n_in != 17 || out_size != M_TOK * DM || ws_size < WS_END) { fprintf(stderr, "kernel_launch: unexpected shapes (n_in %d out %d ws %zu)\n", n_in, out_size, ws_size); grid = -1; return; }
        if (hipFuncSetAttribute((const void*)hybrid_layer_fwd, hipFuncAttributeMaxDynamicSharedMemorySize, LDS_BYTES) != hipSuccess) { fprintf(stderr, "kernel_launch: hipFuncSetAttribute failed\n"); grid = -1; return; }
        int dev = 0, cus = 0, per_cu = 0;
        (void)hipGetDevice(&dev); (void)hipDeviceGetAttribute(&cus, hipDeviceAttributeMultiprocessorCount, dev);
        if (hipOccupancyMaxActiveBlocksPerMultiprocessor(&per_cu, (const void*)hybrid_layer_fwd, 512, LDS_BYTES) != hipSuccess || per_cu < 1) { fprintf(stderr, "kernel_launch: occupancy query says %d blocks/CU\n", per_cu); per_cu = 1; }
        (void)hipGetLastError();
        grid = cus > 0 ? cus : 256;
    }
    if (grid < 0) return;
    (void)hipMemsetAsync((unsigned char*)d_ws + WS_CTL, 0, 32768, stream);
    Params P{};
    for (int i = 0; i < 17; ++i) P.in[i] = (const float*)d_in[i];
    P.out = (float*)d_out; P.ws = (unsigned char*)d_ws;
#if MK_LAUNCHES == 1
    P.ph_lo = 0; P.ph_hi = NPHASE;
    void* args[] = {&P};
    hipError_t e = hipLaunchCooperativeKernel((const void*)hybrid_layer_fwd, dim3(grid), dim3(512), args, LDS_BYTES, stream);
    if (e != hipSuccess) fprintf(stderr, "kernel_launch: cooperative launch failed: %s (grid %d)\n", hipGetErrorString(e), grid);
#else
    for (int ph = 0; ph < NPHASE; ++ph) { P.ph_lo = ph; P.ph_hi = ph + 1;
        hipLaunchKernelGGL(hybrid_layer_fwd, dim3(grid), dim3(512), LDS_BYTES, stream, P); }
#endif
}
```
